# Optimizing an MI355X kernel written in HIP

```python
import math
import jax, jax.numpy as jnp
from jax import lax
import numpy as np

D_MODEL = 2048
BATCH = 2
SEQ = 8192
DEPTH = 2

HEAD_DIM = 128
N_HEADS = D_MODEL // HEAD_DIM
N_FOX_HEADS = N_HEADS // 2
N_NSA_HEADS = N_HEADS - N_FOX_HEADS
NSA_GROUP = 4
NSA_KV_HEADS = N_NSA_HEADS // NSA_GROUP
D_MIX = (N_FOX_HEADS + N_NSA_HEADS) * HEAD_DIM
CMP_BLOCK = 32
CMP_STRIDE = 16
SLC_BLOCK = 64
SLC_TOPK = 16
WINDOW = 512
Q_BLOCK = 128
D_FF = -(-8 * D_MODEL // (3 * 256)) * 256
RMS_EPS = 1e-6
NEG_INF = -1e30
FORCE_SCORE = 1e9

FOX_W = N_FOX_HEADS * HEAD_DIM
NSA_W = N_NSA_HEADS * HEAD_DIM
KV_W = NSA_KV_HEADS * HEAD_DIM
IN_SPLITS = (FOX_W, FOX_W, FOX_W, N_FOX_HEADS, NSA_W, KV_W, KV_W, KV_W, KV_W, KV_W, KV_W, 3 * N_NSA_HEADS)
IN_WIDTH = sum(IN_SPLITS)

kernel_name = "hybrid_fox_nsa_parallel_heads"


def _rms_norm(x, g):
    xf = x.astype(jnp.float32)
    y = xf * lax.rsqrt(jnp.mean(xf * xf, axis=-1, keepdims=True) + RMS_EPS)
    return (y * g.astype(jnp.float32)).astype(x.dtype)


def _masked_softmax(s, mask):
    s = jnp.where(mask, s, NEG_INF)
    m = jnp.max(s, axis=-1, keepdims=True)
    p = jnp.where(mask, jnp.exp(s - m), 0.0)
    return p / jnp.maximum(jnp.sum(p, axis=-1, keepdims=True), 1e-30)


def _alibi_slopes(n):
    return jnp.exp2(-8.0 * jnp.arange(1, n + 1, dtype=jnp.float32) / n)


def _overlap_matrix(n_cmp, n_slc):
    ci = np.arange(n_cmp)[:, None]
    sj = np.arange(n_slc)[None, :]
    ov = (ci * CMP_STRIDE < (sj + 1) * SLC_BLOCK) & (ci * CMP_STRIDE + CMP_BLOCK > sj * SLC_BLOCK)
    return ov.astype(np.float32)


def _compress(tok, pos_emb, w):
    B, T, G, Dh = tok.shape
    chunks = tok.reshape(B, T // CMP_STRIDE, CMP_STRIDE, G, Dh)
    blocks = jnp.concatenate([chunks[:, :-1], chunks[:, 1:]], axis=2)
    return jnp.einsum("bnlgd,lde->bnge", blocks + pos_emb[None, None, :, None, :], w)


def _hybrid_mixer(h, w_in, fox_forget_bias, fox_q_norm, fox_k_norm, nsa_q_norm, cmp_k_norm,
                  slc_k_norm, win_k_norm, cmp_pos_k, cmp_pos_v, cmp_w_k, cmp_w_v, w_out):
    B, T, _ = h.shape
    dt = h.dtype
    f32 = jnp.float32
    Hf, Hn, G, R, Dh = N_FOX_HEADS, N_NSA_HEADS, NSA_KV_HEADS, NSA_GROUP, HEAD_DIM
    scale = HEAD_DIM ** -0.5
    n_cmp = T // CMP_STRIDE - 1
    n_slc = T // SLC_BLOCK
    k_sel = min(SLC_TOPK, n_slc)
    n_qb = T // Q_BLOCK

    proj = h @ w_in
    cuts = [int(c) for c in np.cumsum(IN_SPLITS)[:-1]]
    qf, kf, vf, ff, qn, kc, vc, ks, vs, kw, vw, gt = jnp.split(proj, cuts, axis=-1)

    qf = _rms_norm(qf.reshape(B, T, Hf, Dh), fox_q_norm)
    kf = _rms_norm(kf.reshape(B, T, Hf, Dh), fox_k_norm)
    vf = vf.reshape(B, T, Hf, Dh)
    log_f = jax.nn.log_sigmoid(ff.astype(f32) + fox_forget_bias.astype(f32))
    cum_f = jnp.transpose(jnp.cumsum(log_f, axis=1), (0, 2, 1))

    qn = _rms_norm(qn.reshape(B, T, G, R, Dh), nsa_q_norm)
    k_cmp = _rms_norm(_compress(kc.reshape(B, T, G, Dh), cmp_pos_k, cmp_w_k), cmp_k_norm)
    v_cmp = _compress(vc.reshape(B, T, G, Dh), cmp_pos_v, cmp_w_v)
    cmp_end = jnp.arange(n_cmp) * CMP_STRIDE + (CMP_BLOCK - 1)
    k_slc = jnp.transpose(_rms_norm(ks.reshape(B, n_slc, SLC_BLOCK, G, Dh), slc_k_norm), (0, 3, 1, 2, 4))
    v_slc = jnp.transpose(vs.reshape(B, n_slc, SLC_BLOCK, G, Dh), (0, 3, 1, 2, 4))
    pad = ((0, 0), (WINDOW, 0), (0, 0), (0, 0))
    k_win = jnp.pad(_rms_norm(kw.reshape(B, T, G, Dh), win_k_norm), pad)
    v_win = jnp.pad(vw.reshape(B, T, G, Dh), pad)
    gates = jax.nn.sigmoid(gt.astype(f32)).astype(dt).reshape(B, T, G, R, 3)

    slopes = _alibi_slopes(Hn).reshape(G, R)
    overlap = jnp.asarray(_overlap_matrix(n_cmp, n_slc))
    key_pos = jnp.arange(T)
    blk_ids = jnp.arange(n_slc)
    bi = jnp.arange(B)[:, None, None, None]
    gi = jnp.arange(G)[None, :, None, None]
    win_off = jnp.arange(Q_BLOCK + WINDOW) - WINDOW
    slc_off = jnp.arange(SLC_BLOCK)

    def query_block(i):
        q0 = i * Q_BLOCK
        tpos = q0 + jnp.arange(Q_BLOCK)

        qf_b = lax.dynamic_slice_in_dim(qf, q0, Q_BLOCK, axis=1)
        cq = lax.dynamic_slice_in_dim(cum_f, q0, Q_BLOCK, axis=2)
        s = jnp.einsum("bqhd,bkhd->bhqk", qf_b, kf).astype(f32) * scale
        s = s + cq[..., None] - cum_f[:, :, None, :]
        p = _masked_softmax(s, key_pos[None, :] <= tpos[:, None])
        o_fox = jnp.einsum("bhqk,bkhd->bqhd", p.astype(dt), vf)

        qn_b = lax.dynamic_slice_in_dim(qn, q0, Q_BLOCK, axis=1)

        dist_c = (tpos[:, None] - cmp_end[None, :]).astype(f32)
        s_c = jnp.einsum("bqgrd,bngd->bgrqn", qn_b, k_cmp).astype(f32) * scale
        s_c = s_c - slopes[None, :, :, None, None] * dist_c
        p_c = _masked_softmax(s_c, dist_c >= 0)
        o_c = jnp.einsum("bgrqn,bngd->bqgrd", p_c.astype(dt), v_cmp)

        imp = jnp.einsum("bgrqn,nj->bgqj", p_c, overlap)
        cur = tpos // SLC_BLOCK
        forced = (blk_ids[None, :] == 0) | (blk_ids[None, :] == cur[:, None]) | (blk_ids[None, :] == cur[:, None] - 1)
        valid = blk_ids[None, :] * SLC_BLOCK <= tpos[:, None]
        imp = jnp.where(forced, FORCE_SCORE, jnp.where(valid, imp, -FORCE_SCORE))
        _, idx = lax.top_k(imp, k_sel)
        k_g = k_slc[bi, gi, idx]
        v_g = v_slc[bi, gi, idx]
        spos = idx[..., None] * SLC_BLOCK + slc_off
        dist_s = (tpos[None, None, :, None, None] - spos).astype(f32)[:, :, None]
        s_s = jnp.einsum("bqgrd,bgqkld->bgrqkl", qn_b, k_g).astype(f32) * scale
        s_s = s_s - slopes[None, :, :, None, None, None] * dist_s
        flat = (B, G, R, Q_BLOCK, k_sel * SLC_BLOCK)
        mask_s = jnp.broadcast_to(dist_s >= 0, s_s.shape).reshape(flat)
        p_s = _masked_softmax(s_s.reshape(flat), mask_s).reshape(s_s.shape)
        o_s = jnp.einsum("bgrqkl,bgqkld->bqgrd", p_s.astype(dt), v_g)

        k_wb = lax.dynamic_slice_in_dim(k_win, q0, Q_BLOCK + WINDOW, axis=1)
        v_wb = lax.dynamic_slice_in_dim(v_win, q0, Q_BLOCK + WINDOW, axis=1)
        wpos = q0 + win_off
        dist_w = tpos[:, None] - wpos[None, :]
        mask_w = (dist_w >= 0) & (dist_w < WINDOW) & (wpos[None, :] >= 0)
        s_w = jnp.einsum("bqgrd,bkgd->bgrqk", qn_b, k_wb).astype(f32) * scale
        s_w = s_w - slopes[None, :, :, None, None] * dist_w.astype(f32)
        p_w = _masked_softmax(s_w, mask_w)
        o_w = jnp.einsum("bgrqk,bkgd->bqgrd", p_w.astype(dt), v_wb)

        g_b = lax.dynamic_slice_in_dim(gates, q0, Q_BLOCK, axis=1)
        o_nsa = g_b[..., 0:1] * o_c + g_b[..., 1:2] * o_s + g_b[..., 2:3] * o_w
        return o_fox, o_nsa.reshape(B, Q_BLOCK, Hn, Dh)

    o_fox, o_nsa = lax.map(query_block, jnp.arange(n_qb))
    o_fox = jnp.moveaxis(o_fox, 0, 1).reshape(B, T, FOX_W)
    o_nsa = jnp.moveaxis(o_nsa, 0, 1).reshape(B, T, NSA_W)
    return jnp.concatenate([o_fox, o_nsa], axis=-1) @ w_out


def _swiglu(h, w_gate, w_up, w_down):
    return (jax.nn.silu(h @ w_gate) * (h @ w_up)) @ w_down


def setup_inputs(seed: int = 0) -> dict:
    key = jax.random.key(seed)
    ks = jax.random.split(key, 20)
    f32 = jnp.float32
    nrm = lambda k, shape, s: jax.random.normal(k, shape, f32) * s
    gain = lambda k, shape: 1.0 + 0.02 * jax.random.normal(k, shape, f32)
    L = DEPTH
    return {
        "x": nrm(ks[0], (BATCH, SEQ, D_MODEL), 1.0),
        "attn_norm": gain(ks[1], (L, D_MODEL)),
        "w_in": nrm(ks[2], (L, D_MODEL, IN_WIDTH), D_MODEL ** -0.5),
        "fox_forget_bias": 3.0 + 0.5 * jax.random.normal(ks[3], (L, N_FOX_HEADS), f32),
        "fox_q_norm": gain(ks[4], (L, HEAD_DIM)),
        "fox_k_norm": gain(ks[5], (L, HEAD_DIM)),
        "nsa_q_norm": gain(ks[6], (L, HEAD_DIM)),
        "cmp_k_norm": gain(ks[7], (L, HEAD_DIM)),
        "slc_k_norm": gain(ks[8], (L, HEAD_DIM)),
        "win_k_norm": gain(ks[9], (L, HEAD_DIM)),
        "cmp_pos_k": nrm(ks[10], (L, CMP_BLOCK, HEAD_DIM), 0.02),
        "cmp_pos_v": nrm(ks[11], (L, CMP_BLOCK, HEAD_DIM), 0.02),
        "cmp_w_k": nrm(ks[12], (L, CMP_BLOCK, HEAD_DIM, HEAD_DIM), (CMP_BLOCK * HEAD_DIM) ** -0.5),
        "cmp_w_v": nrm(ks[13], (L, CMP_BLOCK, HEAD_DIM, HEAD_DIM), (CMP_BLOCK * HEAD_DIM) ** -0.5),
        "w_out": nrm(ks[14], (L, D_MIX, D_MODEL), D_MIX ** -0.5),
        "ffn_norm": gain(ks[15], (L, D_MODEL)),
        "w_gate": nrm(ks[16], (L, D_MODEL, D_FF), D_MODEL ** -0.5),
        "w_up": nrm(ks[17], (L, D_MODEL, D_FF), D_MODEL ** -0.5),
        "w_down": nrm(ks[18], (L, D_FF, D_MODEL), D_FF ** -0.5),
    }


def reference(x, attn_norm, w_in, fox_forget_bias, fox_q_norm, fox_k_norm, nsa_q_norm, cmp_k_norm,
              slc_k_norm, win_k_norm, cmp_pos_k, cmp_pos_v, cmp_w_k, cmp_w_v, w_out, ffn_norm,
              w_gate, w_up, w_down):
    for l in range(DEPTH):
        h = _rms_norm(x, attn_norm[l])
        x = x + _hybrid_mixer(h, w_in[l], fox_forget_bias[l], fox_q_norm[l], fox_k_norm[l], nsa_q_norm[l],
                              cmp_k_norm[l], slc_k_norm[l], win_k_norm[l], cmp_pos_k[l], cmp_pos_v[l],
                              cmp_w_k[l], cmp_w_v[l], w_out[l])
        h = _rms_norm(x, ffn_norm[l])
        x = x + _swiglu(h, w_gate[l], w_up[l], w_down[l])
    return x
```

```cpp
#include <hip/hip_runtime.h>
#include <hip/hip_cooperative_groups.h>
#include <cstdio>
#include <cstdint>
namespace cg = cooperative_groups;
namespace pg8 {
#define PG8_LAS __attribute__((address_space(3)))
typedef unsigned short bf16_t;
typedef short bf16x8 __attribute__((ext_vector_type(8)));
typedef float f32x4 __attribute__((ext_vector_type(4)));
typedef unsigned u32x4 __attribute__((ext_vector_type(4)));
constexpr int BM = 256, BK = 64, HALF = 128, HTB = HALF * BK * 2  , STAGE_BYTES = 8 * HTB, NXCD = 8, WGM = 8;

__host__ __device__ __forceinline__ int lds_byte(int r, int c) { const int st = (r >> 4) * 2 + (c >> 5), rr = r & 15, cc = c & 31, ob = rr * 64 + cc * 2; return st * 1024 + (ob ^ (((ob >> 9) & 1) << 5)); }
__host__ __device__ __forceinline__ void stage_rc(int b, int& R, int& C) { const int st = b / 1024, sb = b % 1024, swz = sb ^ (((sb >> 9) & 1) << 5); R = (st >> 1) * 16 + swz / 64; C = (st & 1) * 32 + (swz % 64) / 2; }
__host__ __device__ __forceinline__ int perm32(int rho) { const int n = rho >> 4, i = rho & 15; return 8 * (i >> 2) + 4 * n + (i & 3); }

struct Unit { int pm, pn, sw; };
struct Gemm { const bf16_t* A; const bf16_t* Bt; int M, N, K, lda, ldb; const bf16_t* A2; const bf16_t* Bt2; };

struct StaticOrder {
    int nM, nN, nwg, G, c;
    __host__ __device__ void init(int M, int N, int G_, int c_) { nM = M / BM; nN = N / BM; nwg = nM * nN; G = G_; c = c_; }
    __host__ __device__ bool next(int i, Unit& u) const {
        const long L = (long)i * G + c; if (L >= nwg) return false;
        int wgid = (int)L; { const int q = nwg / NXCD, r = nwg % NXCD, xcd = wgid % NXCD, off = wgid / NXCD; wgid = (xcd < r ? xcd * (q + 1) : r * (q + 1) + (xcd - r) * q) + off; }
        const int nig = WGM * nN, gid = wgid / nig, fm = gid * WGM, gsz = (nM - fm) < WGM ? (nM - fm) : WGM;
        u.pm = fm + ((wgid % nig) % gsz); u.pn = (wgid % nig) / gsz; u.sw = 0; return true;
    }
    __device__ __forceinline__ void a_ready(const Unit&) const {}
    __device__ __forceinline__ void done(const Unit&) const {}
};


template <class Epi, class Sched, bool ALIGN_EPI = false, bool SP2 = false>
__device__ __forceinline__ void gemm_phase(PG8_LAS unsigned char* lds, const Gemm g, const Sched& S, const Epi& E, int wv) {
    int ln_; asm volatile("v_mbcnt_lo_u32_b32 %0, -1, 0\n\tv_mbcnt_hi_u32_b32 %0, -1, %0" : "=v"(ln_));
    int wid_ = wv; asm volatile("" : "+s"(wid_));
    const int wid = wid_, tid = wid * 64 + ln_, lane = tid & 63, wr = wid >> 2, wc = wid & 3, fr = lane & 15, fq = lane >> 4;
    const int K = g.K, nt = K / BK;
    unsigned voffA[2], voffB[2];
#pragma unroll
    for (int i = 0; i < 2; ++i) { int R, C; stage_rc(tid * 16 + i * 8192, R, C); const int Rb = Epi::PERM ? ((R & ~31) + perm32(R & 31)) : R;
        voffA[i] = (unsigned)(R * g.lda + C) * 2u; voffB[i] = (unsigned)(Rb * g.ldb + C) * 2u; }
    const size_t kstep = (size_t)(BK * 2);
    const size_t hstepA = (size_t)HALF * g.lda * 2, hstepB = (size_t)HALF * g.ldb * 2;
    const size_t tstepA = 2 * hstepA, tstepB = 2 * hstepB;
    const unsigned ldsw = (unsigned)wid * 1024u;
    const int aoff = lds_byte(wr * 64 + fr, fq * 8), boff = lds_byte(wc * 32 + fr, fq * 8);
#define PG8_SA(b, h) (((b) * 2 + (h)) * HTB)
#define PG8_SB(b, h) ((4 + (b) * 2 + (h)) * HTB)
#define PG8_STAGE(bufoff, gbase, voff) do { _Pragma("unroll") for (int _i = 0; _i < 2; ++_i) \
        __builtin_amdgcn_global_load_lds((const unsigned*)((const char*)(gbase) + (voff)[_i]), (PG8_LAS unsigned*)(lds + (bufoff) + ldsw + _i * 8192), 16, 0, 0); } while (0)
#define PG8_LDA(dst, b, h) do { _Pragma("unroll") for (int m = 0; m < 4; ++m) _Pragma("unroll") for (int k = 0; k < 2; ++k) dst[m][k] = *(const PG8_LAS bf16x8*)(lds + PG8_SA(b, h) + aoff + m * 2048 + k * 1024); } while (0)
#define PG8_LDB(dst, b, h) do { _Pragma("unroll") for (int n = 0; n < 2; ++n) _Pragma("unroll") for (int k = 0; k < 2; ++k) dst[n][k] = *(const PG8_LAS bf16x8*)(lds + PG8_SB(b, h) + boff + n * 2048 + k * 1024); } while (0)
#define PG8_MMA(ai, bj, At, Bt) do { __builtin_amdgcn_s_setprio(1); _Pragma("unroll") for (int m = 0; m < 4; ++m) _Pragma("unroll") for (int n = 0; n < 2; ++n) _Pragma("unroll") for (int k = 0; k < 2; ++k) \
        acc[ai][bj][m][n] = __builtin_amdgcn_mfma_f32_16x16x32_bf16(Bt[n][k], At[m][k], acc[ai][bj][m][n], 0, 0, 0); __builtin_amdgcn_s_setprio(0); } while (0)
#define PG8_WAIT_V(n) asm volatile("s_waitcnt vmcnt(" #n ")" ::: "memory")
#define PG8_WAIT_L(n) asm volatile("s_waitcnt lgkmcnt(" #n ")" ::: "memory")
#define PG8_BAR __builtin_amdgcn_s_barrier()
#define PG8_SCHED __builtin_amdgcn_sched_barrier(0)
    Unit cur, nxt; int ui = 0;
    if (!S.next(0, cur)) return;
    f32x4 acc[2][2][4][2];
#pragma unroll
    for (int a = 0; a < 2; ++a)
#pragma unroll
        for (int b = 0; b < 2; ++b)
#pragma unroll
            for (int m = 0; m < 4; ++m)
#pragma unroll
                for (int n = 0; n < 2; ++n) acc[a][b][m][n] = (f32x4){0.f, 0.f, 0.f, 0.f};
    bf16x8 At[4][2], B0[2][2], B1[2][2];
    const char* cA = (const char*)(cur.sw ? g.A2 : g.A) + (size_t)cur.pm * tstepA; const char* cB = (const char*)(cur.sw ? g.Bt2 : g.Bt) + (size_t)cur.pn * tstepB;
    S.a_ready(cur);
    if constexpr (SP2) {
        PG8_STAGE(PG8_SB(0, 0), cB, voffB); PG8_STAGE(PG8_SB(0, 1), cB + hstepB, voffB); PG8_STAGE(PG8_SA(0, 0), cA, voffA); PG8_STAGE(PG8_SA(0, 1), cA + hstepA, voffA);
        if (wr == 1) PG8_BAR;
        PG8_WAIT_V(2); PG8_BAR;
        PG8_STAGE(PG8_SB(1, 0), cB + kstep, voffB); PG8_STAGE(PG8_SA(1, 0), cA + kstep, voffA); PG8_STAGE(PG8_SB(1, 1), cB + hstepB + kstep, voffB);
        PG8_WAIT_V(6); PG8_BAR;
    } else {
        PG8_STAGE(PG8_SB(0, 0), cB, voffB); PG8_STAGE(PG8_SA(0, 0), cA, voffA); PG8_STAGE(PG8_SB(0, 1), cB + hstepB, voffB); PG8_STAGE(PG8_SA(0, 1), cA + hstepA, voffA);
        if (wr == 1) PG8_BAR;
        PG8_WAIT_V(4); PG8_BAR;
        PG8_STAGE(PG8_SB(1, 0), cB + kstep, voffB); PG8_STAGE(PG8_SA(1, 0), cA + kstep, voffA); PG8_STAGE(PG8_SB(1, 1), cB + hstepB + kstep, voffB);
        PG8_WAIT_V(6); PG8_BAR;
    }
    for (;;) {
        const bool has_next = S.next(ui + 1, nxt);
        const char* nA = has_next ? (const char*)(nxt.sw ? g.A2 : g.A) + (size_t)nxt.pm * tstepA : cA; const char* nB = has_next ? (const char*)(nxt.sw ? g.Bt2 : g.Bt) + (size_t)nxt.pn * tstepB : cB;
        for (int t = 0; t < nt; t += 2) {
            const bool last = (t == nt - 2);
            const char* a1 = cA + (size_t)(t + 1) * kstep;
            const char* a2 = last ? nA : cA + (size_t)(t + 2) * kstep; const char* b2 = last ? nB : cB + (size_t)(t + 2) * kstep;
            const char* a3 = a2 + kstep; const char* b3 = b2 + kstep;
            if (last && has_next) S.a_ready(nxt);
            if constexpr (SP2) {
            PG8_LDB(B0, 0, 0); PG8_LDB(B1, 0, 1); PG8_SCHED; PG8_LDA(At, 0, 0); PG8_STAGE(PG8_SA(1, 1), a1 + hstepA, voffA);
            PG8_WAIT_V(8); PG8_WAIT_L(0); PG8_BAR; PG8_MMA(0, 0, At, B0); PG8_MMA(0, 1, At, B1); PG8_BAR; PG8_SCHED;
            PG8_LDA(At, 0, 1); PG8_STAGE(PG8_SB(0, 0), b2, voffB); PG8_STAGE(PG8_SB(0, 1), b2 + hstepB, voffB); PG8_STAGE(PG8_SA(0, 0), a2, voffA);
            PG8_WAIT_V(8); PG8_WAIT_L(0); PG8_BAR; PG8_MMA(1, 0, At, B0); PG8_MMA(1, 1, At, B1); PG8_BAR; PG8_SCHED;
            PG8_LDB(B0, 1, 0); PG8_LDB(B1, 1, 1); PG8_SCHED; PG8_LDA(At, 1, 0); PG8_STAGE(PG8_SA(0, 1), a2 + hstepA, voffA);
            PG8_WAIT_V(8); PG8_WAIT_L(0); PG8_BAR; PG8_MMA(0, 0, At, B0); PG8_MMA(0, 1, At, B1); PG8_BAR; PG8_SCHED;
            PG8_LDA(At, 1, 1); PG8_STAGE(PG8_SB(1, 0), b3, voffB); PG8_STAGE(PG8_SB(1, 1), b3 + hstepB, voffB); PG8_STAGE(PG8_SA(1, 0), a3, voffA);
            PG8_WAIT_V(8); PG8_WAIT_L(0); PG8_BAR; PG8_MMA(1, 0, At, B0); PG8_MMA(1, 1, At, B1); PG8_BAR; PG8_SCHED;
            } else {
            PG8_LDB(B0, 0, 0); PG8_SCHED; PG8_LDA(At, 0, 0); PG8_STAGE(PG8_SA(1, 1), a1 + hstepA, voffA);
            PG8_WAIT_L(8); PG8_BAR; PG8_WAIT_L(0); PG8_MMA(0, 0, At, B0); PG8_BAR; PG8_SCHED;
            PG8_LDB(B1, 0, 1); PG8_STAGE(PG8_SB(0, 0), b2, voffB);
            PG8_BAR; PG8_WAIT_L(0); PG8_MMA(0, 1, At, B1); PG8_BAR;
            PG8_LDA(At, 0, 1); PG8_STAGE(PG8_SA(0, 0), a2, voffA);
            PG8_BAR; PG8_WAIT_L(0); PG8_MMA(1, 0, At, B0); PG8_BAR; PG8_SCHED;
            PG8_STAGE(PG8_SB(0, 1), b2 + hstepB, voffB);
            PG8_WAIT_V(6); PG8_BAR; PG8_MMA(1, 1, At, B1); PG8_BAR;
            PG8_LDB(B0, 1, 0); PG8_SCHED; PG8_LDA(At, 1, 0); PG8_STAGE(PG8_SA(0, 1), a2 + hstepA, voffA);
            PG8_WAIT_L(8); PG8_BAR; PG8_WAIT_L(0); PG8_MMA(0, 0, At, B0); PG8_BAR; PG8_SCHED;
            PG8_LDB(B1, 1, 1); PG8_STAGE(PG8_SB(1, 0), b3, voffB);
            PG8_BAR; PG8_WAIT_L(0); PG8_MMA(0, 1, At, B1); PG8_BAR;
            PG8_LDA(At, 1, 1); PG8_STAGE(PG8_SA(1, 0), a3, voffA);
            PG8_BAR; PG8_WAIT_L(0); PG8_MMA(1, 0, At, B0); PG8_BAR; PG8_SCHED;
            PG8_STAGE(PG8_SB(1, 1), b3 + hstepB, voffB);
            PG8_WAIT_V(6); PG8_BAR; PG8_MMA(1, 1, At, B1); PG8_BAR;
            }
        }
        if constexpr (ALIGN_EPI) { if (wr == 0) PG8_BAR; }
        if constexpr (!Epi::AFTER_DRAIN) { E(acc, cur, wr, wc, fr, fq); S.done(cur); }
        if (!has_next) break;
#pragma unroll
        for (int a = 0; a < 2; ++a)
#pragma unroll
            for (int b = 0; b < 2; ++b)
#pragma unroll
                for (int m = 0; m < 4; ++m)
#pragma unroll
                    for (int n = 0; n < 2; ++n) acc[a][b][m][n] = (f32x4){0.f, 0.f, 0.f, 0.f};
        cur = nxt; cA = nA; cB = nB; ++ui;
        if constexpr (ALIGN_EPI) { if (wr == 1) PG8_BAR; }
    }
    PG8_WAIT_V(0);
    if constexpr (!ALIGN_EPI) { if (wr == 0) PG8_BAR; }
    PG8_BAR;
    if constexpr (Epi::AFTER_DRAIN) { E.fused(acc, cur, wr, wc, fr, fq, lds, wid, lane); S.done(cur); }
#undef PG8_SA
#undef PG8_SB
#undef PG8_STAGE
#undef PG8_LDA
#undef PG8_LDB
#undef PG8_MMA
#undef PG8_WAIT_V
#undef PG8_WAIT_L
#undef PG8_BAR
#undef PG8_SCHED
}
}
#define LAS __attribute__((address_space(3)))
typedef unsigned short bf16;
typedef unsigned u32x4 __attribute__((ext_vector_type(4)));
typedef unsigned u32x2 __attribute__((ext_vector_type(2)));
typedef float f32x4 __attribute__((ext_vector_type(4)));
typedef float f32x16 __attribute__((ext_vector_type(16)));
typedef short bf16x8 __attribute__((ext_vector_type(8)));
typedef short s16x4 __attribute__((ext_vector_type(4)));
typedef LAS unsigned char* ldsp;
typedef unsigned long long u64;
#define DI __device__ __forceinline__
DI int tid_of(int wv) { int ln; asm volatile("v_mbcnt_lo_u32_b32 %0, -1, 0\n\tv_mbcnt_hi_u32_b32 %0, -1, %0" : "=v"(ln)); return wv * 64 + ln; }
DI float shx(float v, int m, int lane) { return __builtin_bit_cast(float, __builtin_amdgcn_ds_bpermute((lane ^ m) << 2, __builtin_bit_cast(int, v))); }
DI float shup(float v, int d, int lane) { const int src = lane >= d ? lane - d : lane; return __builtin_bit_cast(float, __builtin_amdgcn_ds_bpermute(src << 2, __builtin_bit_cast(int, v))); }

constexpr int BATCH = 2, T = 8192, DM = 2048, M = BATCH * T, FF = 5632, INW = 5664, HD = 128;
constexpr int N1 = 4352, N2 = 1536, NGU = 2 * FF;
constexpr float EPS = 1e-6f;
constexpr float LOG2E = 1.4426950408889634f;
constexpr float C2 = 0.08838834764831845f * 1.4426950408889634f;
constexpr int NWAVES = 8, NTHR = 512;
constexpr int LDS_BYTES = 147456;

constexpr size_t MiB = 1u << 20;
constexpr size_t WL = 99 * MiB;
constexpr size_t OW1 = 0, OW2 = 17 * MiB, OWO = 23 * MiB, OWGU = 31 * MiB, OWD = 75 * MiB, OWC = 97 * MiB;
constexpr size_t WS_HEADS = 198 * MiB, WS_VT = 326 * MiB, WS_H = 198 * MiB;
constexpr size_t WS_OMIX = 374 * MiB, WS_XB = 438 * MiB;
constexpr size_t WS_MISC = 502 * MiB;
constexpr size_t WS_SCAL = WS_MISC, WS_CUMB = WS_MISC + 2 * MiB, WS_KCRAW = WS_MISC + 3 * MiB, WS_KCMP = WS_MISC + 4 * MiB,
                 WS_VCT = WS_MISC + 4 * MiB + 512 * 1024, WS_SS = WS_MISC + 5 * MiB, WS_PB = WS_SS + 4 * 65536,
                 WS_KRAW2 = WS_MISC + 6 * MiB  , WS_VRAW2 = WS_MISC + 8 * MiB  , WS_END = WS_MISC + 10 * MiB;
constexpr size_t WS_BAR = WS_PB + 4096, WS_CCTR = WS_BAR + 14336;
constexpr size_t ZERO_OFF = WS_SS + 65536, ZERO_BYTES = 3 * 65536 + 4096 + 16384;

DI unsigned f2bf(float f) { unsigned u = __builtin_bit_cast(unsigned, f); return (u + 0x7fffu + ((u >> 16) & 1u)) >> 16; }
typedef float f32x2_t __attribute__((ext_vector_type(2)));
typedef __bf16 bf16x2_t __attribute__((ext_vector_type(2)));
DI unsigned pk2(float lo, float hi) { f32x2_t v = {lo, hi}; bf16x2_t b = __builtin_convertvector(v, bf16x2_t); return __builtin_bit_cast(unsigned, b); }
DI float bf2f(unsigned short b) { return __builtin_bit_cast(float, (unsigned)b << 16); }
DI float fexp2(float x) { return __builtin_amdgcn_exp2f(x); }

struct EpiProj {
    static constexpr bool PERM = true, AFTER_DRAIN = false;
    bf16* heads; float* scal; const float* ss;
    DI void operator()(const f32x4 (&acc)[2][2][4][2], const pg8::Unit& u, int wr, int wc, int fr, int fq) const {
#pragma unroll
        for (int ai = 0; ai < 2; ++ai)
#pragma unroll
            for (int m = 0; m < 4; ++m) {
                const int row = u.pm * 256 + ai * 128 + wr * 64 + m * 16 + fr;
                const float rs = rsqrtf(ss[row] * (1.0f / DM) + EPS);
                if (u.pn < 16) {
#pragma unroll
                    for (int bj = 0; bj < 2; ++bj) {
                        const int slot = 2 * u.pn + bj;
                        bf16* dst = heads + ((size_t)slot * M + row) * HD + wc * 32 + 8 * fq;
                        const f32x4 a = acc[ai][bj][m][0] * rs, b = acc[ai][bj][m][1] * rs;
                        u32x4 w; w.x = pk2(a[0], a[1]); w.y = pk2(a[2], a[3]); w.z = pk2(b[0], b[1]); w.w = pk2(b[2], b[3]);
                        *(u32x4*)dst = w;
                    }
                } else if (wc == 0) {
                    float* dst = scal + (size_t)row * 32 + 8 * fq;
                    *(f32x4*)dst = acc[ai][0][m][0] * rs; *(f32x4*)(dst + 4) = acc[ai][0][m][1] * rs;
                }
            }
    }
};
struct EpiVT {
    static constexpr bool PERM = true, AFTER_DRAIN = false;
    bf16* vt; const float* ss;
    DI void operator()(const f32x4 (&acc)[2][2][4][2], const pg8::Unit& u, int wr, int wc, int fr, int fq) const {
        float rs[2][8];
#pragma unroll
        for (int bj = 0; bj < 2; ++bj) { const int c0 = u.pn * 256 + bj * 128 + wc * 32 + 8 * fq;
#pragma unroll
            for (int e = 0; e < 8; ++e) rs[bj][e] = rsqrtf(ss[c0 + e] * (1.0f / DM) + EPS); }
#pragma unroll
        for (int ai = 0; ai < 2; ++ai)
#pragma unroll
            for (int m = 0; m < 4; ++m) {
                const int row = u.pm * 256 + ai * 128 + wr * 64 + m * 16 + fr;
#pragma unroll
                for (int bj = 0; bj < 2; ++bj) {
                    const int c0 = u.pn * 256 + bj * 128 + wc * 32 + 8 * fq;
                    const f32x4 a = acc[ai][bj][m][0], b = acc[ai][bj][m][1];
                    u32x4 w; w.x = pk2(a[0] * rs[bj][0], a[1] * rs[bj][1]); w.y = pk2(a[2] * rs[bj][2], a[3] * rs[bj][3]);
                    w.z = pk2(b[0] * rs[bj][4], b[1] * rs[bj][5]); w.w = pk2(b[2] * rs[bj][6], b[3] * rs[bj][7]);
                    *(u32x4*)(vt + (((size_t)(row >> 7) * (M / 64) + (c0 >> 6)) * 128 + (row & 127)) * 64 + (c0 & 63)) = w;
                }
            }
    }
};
struct EpiRes {
    static constexpr bool PERM = true, AFTER_DRAIN = false;
    float* xout; bf16* xb; float* ssout; ldsp red;
    DI void operator()(const f32x4 (&acc)[2][2][4][2], const pg8::Unit& u, int wr, int wc, int fr, int fq) const {
#pragma unroll
        for (int ai = 0; ai < 2; ++ai)
#pragma unroll
            for (int m = 0; m < 4; ++m) {
                const int row = u.pm * 256 + ai * 128 + wr * 64 + m * 16 + fr;
                float sq = 0.f;
#pragma unroll
                for (int bj = 0; bj < 2; ++bj) {
                    const size_t off = (size_t)row * DM + u.pn * 256 + bj * 128 + wc * 32 + 8 * fq;
                    const u32x4 r = *(const u32x4*)(xb + off);
                    f32x4 a, b;
                    a[0] = __builtin_bit_cast(float, r.x << 16); a[1] = __builtin_bit_cast(float, r.x & 0xffff0000u); a[2] = __builtin_bit_cast(float, r.y << 16); a[3] = __builtin_bit_cast(float, r.y & 0xffff0000u);
                    b[0] = __builtin_bit_cast(float, r.z << 16); b[1] = __builtin_bit_cast(float, r.z & 0xffff0000u); b[2] = __builtin_bit_cast(float, r.w << 16); b[3] = __builtin_bit_cast(float, r.w & 0xffff0000u);
                    a += acc[ai][bj][m][0]; b += acc[ai][bj][m][1];
                    if (xout) { *(f32x4*)(xout + off) = a; *(f32x4*)(xout + off + 4) = b; }
                    else { u32x4 w; w.x = pk2(a[0], a[1]); w.y = pk2(a[2], a[3]); w.z = pk2(b[0], b[1]); w.w = pk2(b[2], b[3]); *(u32x4*)(xb + off) = w; }
                    sq += (a[0] * a[0] + a[1] * a[1]) + (a[2] * a[2] + a[3] * a[3]) + (b[0] * b[0] + b[1] * b[1]) + (b[2] * b[2] + b[3] * b[3]);
                }
                if (ssout) { const int lane_ = fq * 16 + fr; sq += shx(sq, 16, lane_); sq += shx(sq, 32, lane_);
                    if (fq == 0) *(LAS float*)(red + ((ai * 128 + wr * 64 + m * 16 + fr) * 4 + wc) * 4) = sq; }
            }
        if (ssout) {
            asm volatile("s_waitcnt lgkmcnt(0)" ::: "memory");
            __builtin_amdgcn_s_barrier();
            asm volatile("" ::: "memory");
            const int tid_ = (wr * 4 + wc) * 64 + fq * 16 + fr;
            if (tid_ < 256) { const f32x4 pr = *(const LAS f32x4*)(red + tid_ * 16); atomicAdd(ssout + u.pm * 256 + tid_, (pr[0] + pr[1]) + (pr[2] + pr[3])); }
        }
    }
};
struct EpiGU {
    static constexpr bool PERM = true, AFTER_DRAIN = false;
    bf16* h; const float* ss;
    DI void operator()(const f32x4 (&acc)[2][2][4][2], const pg8::Unit& u, int wr, int wc, int fr, int fq) const {
#pragma unroll
        for (int ai = 0; ai < 2; ++ai)
#pragma unroll
            for (int m = 0; m < 4; ++m) {
                const int row = u.pm * 256 + ai * 128 + wr * 64 + m * 16 + fr;
                const float rs = rsqrtf(ss[row] * (1.0f / DM) + EPS);
                float o[8];
#pragma unroll
                for (int n = 0; n < 2; ++n)
#pragma unroll
                    for (int e = 0; e < 4; ++e) { const float g = acc[ai][0][m][n][e] * rs, up = acc[ai][1][m][n][e] * rs;
                        o[4 * n + e] = g * up * __builtin_amdgcn_rcpf(1.0f + fexp2(-LOG2E * g)); }
                u32x4 w; w.x = pk2(o[0], o[1]); w.y = pk2(o[2], o[3]); w.z = pk2(o[4], o[5]); w.w = pk2(o[6], o[7]);
                *(u32x4*)(h + (size_t)row * FF + u.pn * 128 + wc * 32 + 8 * fq) = w;
            }
    }
};
struct EpiCmpK {
    static constexpr bool PERM = true, AFTER_DRAIN = false;
    float* kraw;
    DI void operator()(const f32x4 (&acc)[2][2][4][2], const pg8::Unit& u, int wr, int wc, int fr, int fq) const {
#pragma unroll
        for (int ai = 0; ai < 2; ++ai)
#pragma unroll
            for (int m = 0; m < 4; ++m) {
                const int row = u.pm * 256 + ai * 128 + wr * 64 + m * 16 + fr;
                float* dst = kraw + (size_t)row * HD + wc * 32 + 8 * fq;
                *(f32x4*)dst = acc[ai][0][m][0]; *(f32x4*)(dst + 4) = acc[ai][0][m][1];
            }
    }
};
struct EpiCmpVraw {
    static constexpr bool PERM = true, AFTER_DRAIN = false;
    float* vraw;
    DI void operator()(const f32x4 (&acc)[2][2][4][2], const pg8::Unit& u, int wr, int wc, int fr, int fq) const {
#pragma unroll
        for (int m = 0; m < 4; ++m) {
            const int e = wr * 64 + m * 16 + fr;
#pragma unroll
            for (int bj = 0; bj < 2; ++bj) {
                float* dst = vraw + (size_t)e * 2048 + u.pn * 256 + bj * 128 + wc * 32 + 8 * fq;
                *(f32x4*)dst = acc[1][bj][m][0]; *(f32x4*)(dst + 4) = acc[1][bj][m][1];
            }
        }
    }
};
struct EpiCmpV {
    static constexpr bool PERM = true, AFTER_DRAIN = false;
    bf16* vct; const float* pbv;
    DI void operator()(const f32x4 (&acc)[2][2][4][2], const pg8::Unit& u, int wr, int wc, int fr, int fq) const {
#pragma unroll
        for (int m = 0; m < 4; ++m) {
            const int e = wr * 64 + m * 16 + fr; const float pb = pbv[e];
#pragma unroll
            for (int bj = 0; bj < 2; ++bj) {
                const int c0 = u.pn * 256 + bj * 128 + wc * 32 + 8 * fq;
                const f32x4 a = acc[1][bj][m][0] + pb, b = acc[1][bj][m][1] + pb;
                u32x4 w; w.x = pk2(a[0], a[1]); w.y = pk2(a[2], a[3]); w.z = pk2(b[0], b[1]); w.w = pk2(b[2], b[3]);
                *(u32x4*)(vct + ((size_t)(c0 >> 6) * 128 + e) * 64 + (c0 & 63)) = w;
            }
        }
    }
};
struct MergedOrder {
    pg8::StaticOrder a, b; int n1, G, c;
    DI void init(int G_, int c_) { a.init(M, N1, 1, 0); b.init(N2, M, 1, 0); n1 = a.nwg; G = G_; c = c_; }
    DI bool next(int i, pg8::Unit& u) const {
        const int L = i * G + c;
        if (L < n1) return a.next(L, u);
        if (L - n1 < b.nwg) { const bool ok = b.next(L - n1, u); u.sw = 1; return ok; }
        return false;
    }
    DI void a_ready(const pg8::Unit&) const {}
    DI void done(const pg8::Unit&) const {}
};
struct EpiInProj {
    static constexpr bool PERM = true, AFTER_DRAIN = false;
    EpiProj a; EpiVT b;
    DI void operator()(const f32x4 (&acc)[2][2][4][2], const pg8::Unit& u, int wr, int wc, int fr, int fq) const { if (u.sw) b(acc, u, wr, wc, fr, fq); else a(acc, u, wr, wc, fr, fq); }
};
struct OneUnit {
    bool has; pg8::Unit u;
    DI bool next(int i, pg8::Unit& o) const { if (i == 0 && has) { o = u; return true; } return false; }
    DI void a_ready(const pg8::Unit&) const {}
    DI void done(const pg8::Unit&) const {}
};
DI float wave_sum(float v, int lane) {
#pragma unroll
    for (int o = 1; o < 64; o <<= 1) v += shx(v, o, lane);
    return v;
}
DI int srccol_in(int type, int n) {
    if (type == 0) {
        if (n < 2048) return n;
        if (n < 3840) return n + 1032;
        if (n < 4096) return n + 1288;
        if (n < 4104) return 3072 + (n - 4096);
        if (n < 4128) return 5640 + (n - 4104);
        return -1;
    }
    if (n < 1024) return 2048 + n;
    if (n < 1280) return 4872 + (n - 1024);
    return 5384 + (n - 1280);
}
DI void tr_item(const float* W, int ldw, int k0, int col, const float* gain, bf16* dst_n0, int K, LAS float* scr, int lane) {
    const int kr = lane >> 4, c4 = lane & 15;
    f32x4 v[16];
#pragma unroll
    for (int i = 0; i < 16; ++i) { v[i] = (f32x4){0.f, 0.f, 0.f, 0.f}; if (col >= 0) v[i] = *(const f32x4*)(W + (size_t)(k0 + 4 * i + kr) * ldw + col); }
    if (gain) {
#pragma unroll
        for (int i = 0; i < 16; ++i) v[i] *= gain[k0 + 4 * i + kr];
    }
#pragma unroll
    for (int i = 0; i < 16; ++i) { LAS float* d = scr + (4 * i + kr) * 65 + 4 * c4; d[0] = v[i][0]; d[1] = v[i][1]; d[2] = v[i][2]; d[3] = v[i][3]; }
    asm volatile("s_waitcnt lgkmcnt(0)" ::: "memory");
    const int c = lane & 7;
#pragma unroll
    for (int j = 0; j < 8; ++j) { const int n = (lane >> 3) + 8 * j; const LAS float* sp = scr + (8 * c) * 65 + n;
        u32x4 o; o.x = pk2(sp[0 * 65], sp[1 * 65]); o.y = pk2(sp[2 * 65], sp[3 * 65]); o.z = pk2(sp[4 * 65], sp[5 * 65]); o.w = pk2(sp[6 * 65], sp[7 * 65]);
        *(u32x4*)(dst_n0 + (size_t)n * K + k0 + 8 * c) = o; }
    asm volatile("s_waitcnt lgkmcnt(0)" ::: "memory");
}

struct P {
    const float *x, *attn_norm, *w_in, *fbias, *fqn, *fkn, *nqn, *ckn, *skn, *wkn, *cpk, *cpv, *cwk, *cwv, *w_out, *ffn_norm, *w_gate, *w_up, *w_down;
    float* out; unsigned char* ws;
};

DI void convert_weights(const P& p, ldsp lds, int l, int part, int nb, int bi, int wv) {
    const int tid = tid_of(wv), lane = tid & 63, wave = tid >> 6;
    LAS float* scr = (LAS float*)(lds + wave * 16640);
    const int gw = bi * NWAVES + wave, NGW = nb * NWAVES;
    constexpr int I1 = 32 * (N1 / 64), I2 = 32 * (N2 / 64), IO = 32 * (DM / 64), IGU = 32 * (NGU / 64), ID = (FF / 64) * (DM / 64), IC = 64 * 4;
    constexpr int IL = I1 + I2 + IO + IGU + ID + IC;
    const int nl = 4 * (lane & 15);
    const int nitems = part == 0 ? I1 + I2 + IC : IO + IGU + ID;
    for (int it = gw; it < nitems; it += NGW) {
        int r = part == 0 ? (it < I1 + I2 ? it : it + (IO + IGU + ID)) : it + I1 + I2;
        unsigned char* wl = p.ws + (size_t)l * WL;
        if (r < I1) { const int nb = r % (N1 / 64), kb = r / (N1 / 64);
            tr_item(p.w_in + (size_t)l * DM * INW, INW, kb * 64, srccol_in(0, nb * 64 + nl), p.attn_norm + l * DM, (bf16*)(wl + OW1) + (size_t)nb * 64 * DM, DM, scr, lane); continue; } r -= I1;
        if (r < I2) { const int nb = r % (N2 / 64), kb = r / (N2 / 64);
            tr_item(p.w_in + (size_t)l * DM * INW, INW, kb * 64, srccol_in(1, nb * 64 + nl), p.attn_norm + l * DM, (bf16*)(wl + OW2) + (size_t)nb * 64 * DM, DM, scr, lane); continue; } r -= I2;
        if (r < IO) { const int nb = r % (DM / 64), kb = r / (DM / 64);
            tr_item(p.w_out + (size_t)l * DM * DM, DM, kb * 64, nb * 64 + nl, nullptr, (bf16*)(wl + OWO) + (size_t)nb * 64 * DM, DM, scr, lane); continue; } r -= IO;
        if (r < IGU) { const int nb = r % (NGU / 64), kb = r / (NGU / 64); const int n = nb * 64, pp = n >> 8, sg = (n >> 7) & 1, j = n & 127;
            tr_item((sg ? p.w_up : p.w_gate) + (size_t)l * DM * FF, FF, kb * 64, 128 * pp + j + nl, p.ffn_norm + l * DM, (bf16*)(wl + OWGU) + (size_t)n * DM, DM, scr, lane); continue; } r -= IGU;
        if (r < ID) { const int nb = r % (DM / 64), kb = r / (DM / 64);
            tr_item(p.w_down + (size_t)l * FF * DM, DM, kb * 64, nb * 64 + nl, nullptr, (bf16*)(wl + OWD) + (size_t)nb * 64 * FF, FF, scr, lane); continue; } r -= ID;
        { const int nb = r % 4, kb = r / 4; const int n = nb * 64;
            tr_item((n < 128 ? p.cwk : p.cwv) + (size_t)l * 4096 * 128, 128, kb * 64, (n & 127) + nl, nullptr, (bf16*)(wl + OWC) + (size_t)n * 4096, 4096, scr, lane); }
    }
}

DI void prologue(const P& p, ldsp lds, int G, int wv) {
    convert_weights(p, lds, 0, 0, G, blockIdx.x, wv);
    const int tid = tid_of(wv), lane = tid & 63, wave = tid >> 6;
    const int gw = blockIdx.x * NWAVES + wave, NGW = G * NWAVES;
    bf16* XB = (bf16*)(p.ws + WS_XB); float* SS0 = (float*)(p.ws + WS_SS);
    for (int m = gw; m < M; m += NGW) {
        const f32x4* xr = (const f32x4*)(p.x + (size_t)m * DM) + lane; u32x2* o8 = (u32x2*)(XB + (size_t)m * DM) + lane;
        float s = 0.f;
#pragma unroll
        for (int j = 0; j < 8; ++j) { const f32x4 v = xr[64 * j]; s += (v.x * v.x + v.y * v.y) + (v.z * v.z + v.w * v.w);
            u32x2 w; w.x = pk2(v.x, v.y); w.y = pk2(v.z, v.w); o8[64 * j] = w; }
        s = wave_sum(s, lane); if (lane == 0) SS0[m] = s;
    }
    float* PB = (float*)(p.ws + WS_PB);
    for (int it = gw; it < 2 * 2 * 2 * 16; it += NGW) {
        const int kc = it & 15, eh = (it >> 4) & 1, kv = (it >> 5) & 1, l = it >> 6;
        const float* pos = (kv ? p.cpv : p.cpk) + (size_t)l * 4096; const float* w = (kv ? p.cwv : p.cwk) + (size_t)l * 4096 * 128;
        const int e = eh * 64 + lane; float a = 0.f;
        for (int k = kc * 256; k < kc * 256 + 256; ++k) a += pos[k] * w[(size_t)k * 128 + e];
        atomicAdd(PB + (l * 2 + kv) * 128 + e, a);
    }
}

DI void post_norm(const P& p, int l, int nb, int bi, int wv) {
    const int tid = tid_of(wv), lane = tid & 63, wave = tid >> 6, sub = lane & 15;
    bf16* heads = (bf16*)(p.ws + WS_HEADS);
    const int gw = bi * NWAVES + wave, NGW = nb * NWAVES;
    constexpr int NIT = 12 * (M / 8);
    for (int it = gw; it < NIT; it += NGW) {
        const int si = it / (M / 8), r8 = it % (M / 8);
        const int slot = si < 8 ? 8 + si : 20 + si;
        const float* gp = (slot < 16 ? p.fkn : (slot < 30 ? p.skn : p.wkn)) + l * HD + sub * 8;
        bf16* rowp0 = heads + ((size_t)slot * M + r8 * 8 + (lane >> 4)) * HD + sub * 8; bf16* rowp1 = rowp0 + 4 * HD;
        const u32x4 raw0 = *(const u32x4*)rowp0, raw1 = *(const u32x4*)rowp1;
        const f32x4 g0 = *(const f32x4*)gp, g1 = *(const f32x4*)(gp + 4);
        float v[8], u[8]; float s0 = 0.f, s1 = 0.f;
#pragma unroll
        for (int j = 0; j < 4; ++j) { v[2 * j] = __builtin_bit_cast(float, raw0[j] << 16); v[2 * j + 1] = __builtin_bit_cast(float, raw0[j] & 0xffff0000u);
            u[2 * j] = __builtin_bit_cast(float, raw1[j] << 16); u[2 * j + 1] = __builtin_bit_cast(float, raw1[j] & 0xffff0000u); }
#pragma unroll
        for (int j = 0; j < 8; ++j) { s0 += v[j] * v[j]; s1 += u[j] * u[j]; }
        s0 += shx(s0, 1, lane); s1 += shx(s1, 1, lane); s0 += shx(s0, 2, lane); s1 += shx(s1, 2, lane);
        s0 += shx(s0, 4, lane); s1 += shx(s1, 4, lane); s0 += shx(s0, 8, lane); s1 += shx(s1, 8, lane);
        const float r0 = rsqrtf(s0 * (1.0f / HD) + EPS), r1 = rsqrtf(s1 * (1.0f / HD) + EPS);
        u32x4 w0, w1;
        w0.x = pk2(v[0] * r0 * g0[0], v[1] * r0 * g0[1]); w0.y = pk2(v[2] * r0 * g0[2], v[3] * r0 * g0[3]); w0.z = pk2(v[4] * r0 * g1[0], v[5] * r0 * g1[1]); w0.w = pk2(v[6] * r0 * g1[2], v[7] * r0 * g1[3]);
        w1.x = pk2(u[0] * r1 * g0[0], u[1] * r1 * g0[1]); w1.y = pk2(u[2] * r1 * g0[2], u[3] * r1 * g0[3]); w1.z = pk2(u[4] * r1 * g1[0], u[5] * r1 * g1[1]); w1.w = pk2(u[6] * r1 * g1[2], u[7] * r1 * g1[3]);
        *(u32x4*)rowp0 = w0; *(u32x4*)rowp1 = w1;
    }
}
DI float log_sigmoid(float z) { const float a = fabsf(z); return fminf(z, 0.f) - 0.6931471805599453f * __builtin_amdgcn_logf(1.0f + fexp2(-LOG2E * a)); }
DI void post_cumsum(const P& p, int l, ldsp lds, int c, int wv) {
    const int tid = tid_of(wv), lane = tid & 63, wave = tid >> 6, b = c >> 3, h = c & 7;
    const float* scal = (const float*)(p.ws + WS_SCAL); float* cumb = (float*)(p.ws + WS_CUMB) + (size_t)c * T;
    const float fb = p.fbias[l * 8 + h];
    float v[16]; float run = 0.f;
#pragma unroll
    for (int j = 0; j < 16; ++j) { const int t = tid * 16 + j; run += log_sigmoid(scal[(size_t)(b * T + t) * 32 + h] + fb); v[j] = run; }
    float inc = run;
#pragma unroll
    for (int o = 1; o < 64; o <<= 1) { const float n = shup(inc, o, lane); if (lane >= o) inc += n; }
    LAS float* wt = (LAS float*)lds;
    if (lane == 63) wt[wave] = inc;
    __syncthreads();
    float base = inc - run;
    for (int w2 = 0; w2 < wave; ++w2) base += wt[w2];
#pragma unroll
    for (int j = 0; j < 16; ++j) cumb[tid * 16 + j] = -LOG2E * (base + v[j]);
    __syncthreads();
}
constexpr int KPITCH = 272, VPITCH = 144, TILEB = 17408, TILEV = 128 * VPITCH;
constexpr int A_K = 0, A_V = 2 * TILEB, A_BIAS = A_V + 2 * TILEV, A_IMPG = A_BIAS + 512, A_IMP3 = A_IMPG + 32768, A_SEL = A_IMP3 + 32768, A_WUN = A_SEL + 1024, A_LIST = A_WUN + 128;
static_assert(A_LIST + 1024 <= LDS_BYTES, "attention LDS map");
#define MFMA32(a, b, c) __builtin_amdgcn_mfma_f32_32x32x16_bf16((a), (b), (c), 0, 0, 0)
enum { MD_FOX = 0, MD_CMP1 = 1, MD_CMP2 = 2, MD_SEL = 3, MD_WIN = 4 };

struct TileRegs { u32x4 k0, k1, v0, v1; f32x4 b; };
template <int MODE> DI void tile_gload(TileRegs& r, const bf16* kt, const bf16* vt, size_t vpitch, const float* bias, int tid) {
    r.k0 = *(const u32x4*)(kt + tid * 8); r.k1 = *(const u32x4*)(kt + (tid + 512) * 8);
    if (MODE != MD_CMP1) {
        r.v0 = *(const u32x4*)(vt + tid * 8);
        r.v1 = *(const u32x4*)(vt + (tid + 512) * 8);
    }
    if (MODE == MD_FOX) { if (tid < 16) r.b = *(const f32x4*)(bias + tid * 4); }
}
template <int MODE> DI void tile_swrite(const TileRegs& r, ldsp lds, int koff, int voff, int boff, int tid) {
    ldsp kb = lds + koff, vb = lds + voff;
    *(LAS u32x4*)(kb + (tid >> 4) * KPITCH + (tid & 15) * 16) = r.k0;
    *(LAS u32x4*)(kb + ((tid >> 4) + 32) * KPITCH + (tid & 15) * 16) = r.k1;
    if (MODE != MD_CMP1) {
        const int cw = ((tid & 7) >> 1) * 32 + (tid & 1) * 8;
        ldsp a0 = vb + (tid >> 3) * VPITCH + cw, a1 = vb + ((tid >> 3) + 64) * VPITCH + cw;
        u32x2 t; t.x = r.v0.x; t.y = r.v0.y; *(LAS u32x2*)a0 = t; t.x = r.v0.z; t.y = r.v0.w; *(LAS u32x2*)(a0 + 16) = t;
        t.x = r.v1.x; t.y = r.v1.y; *(LAS u32x2*)a1 = t; t.x = r.v1.z; t.y = r.v1.w; *(LAS u32x2*)(a1 + 16) = t;
    }
    if (MODE == MD_FOX) { if (tid < 16) *(LAS f32x4*)(lds + A_BIAS + boff + tid * 16) = r.b; }
}

struct AttnCtx {
    const bf16* kmat; const bf16* vtm; size_t vpitch; const float* cumb;
    int ntiles, tile0;
    int t; float slope2;
    int whi;
    int mtile;
    u64 wun_lo, wun_hi;
    float m, l;
    float bqk;
    bool xsel;
    int qi;
};

template <int MODE> DI void attn_h1(AttnCtx& c, const bf16x8 (&q)[8], f32x16 (&o)[4], f32x16& s0, f32x16& s1, ldsp lds, int kbuf, int bbuf, int tj, int lane) {
    const int r32 = lane & 31, h = lane >> 5;
            ldsp kl = lds + kbuf + r32 * KPITCH + h * 16;
#pragma unroll
            for (int e = 0; e < 16; ++e) { s0[e] = 0.f; s1[e] = 0.f; }
#pragma unroll
            for (int s = 0; s < 8; ++s) {
                const bf16x8 ka = *(const LAS bf16x8*)(kl + s * 32), kb = *(const LAS bf16x8*)(kl + 32 * KPITCH + s * 32);
                s0 = MFMA32(ka, q[s], s0); s1 = MFMA32(kb, q[s], s1);
                if (s == 3) asm volatile("" ::: "memory");
            }
            const float NINF = -__builtin_inff();
            if (MODE == MD_FOX) {
                const LAS float* bl = (const LAS float*)(lds + A_BIAS + bbuf);
                const int kbase = tj * 64 + 4 * h;
                const bool needmask = tj >= c.whi;
#pragma unroll
                for (int g4 = 0; g4 < 4; ++g4) {
                    const f32x4 b0 = *(const LAS f32x4*)(bl + 8 * g4 + 4 * h), b1 = *(const LAS f32x4*)(bl + 32 + 8 * g4 + 4 * h);
#pragma unroll
                    for (int e = 0; e < 4; ++e) { s0[4 * g4 + e] += b0[e]; s1[4 * g4 + e] += b1[e]; }
                }
                if (needmask) {
#pragma unroll
                    for (int e = 0; e < 16; ++e) {
                        const int k0 = kbase + 8 * (e >> 2) + (e & 3);
                        s0[e] = (k0 <= c.t) ? s0[e] : NINF; s1[e] = (k0 + 32 <= c.t) ? s1[e] : NINF;
                    }
                }
            } else {
                constexpr bool CMP = (MODE == MD_CMP1 || MODE == MD_CMP2);
                constexpr int PS = CMP ? 16 : 1;
                const int P0 = CMP ? tj * 1024 + 31 : tj * 64;
                const float dbase = (float)(c.t - P0 - PS * 4 * h);
                bool selbit = true;
                if (MODE == MD_SEL) selbit = ((*(const LAS unsigned*)(lds + A_SEL + c.qi * 16 + (tj >> 5) * 4) >> (tj & 31)) & 1u) != 0u;
                bool needmask = true;
                if (MODE == MD_WIN) needmask = (tj == c.mtile) || (tj + 8 == c.mtile);
                if (MODE == MD_SEL) needmask = (tj >= c.mtile);
                if (needmask) {
#pragma unroll
                    for (int e = 0; e < 16; ++e) {
                        const float d0 = dbase - (float)(PS * (8 * (e >> 2) + (e & 3))), d1 = d0 - (float)(PS * 32);
                        bool v0 = d0 >= 0.f, v1 = d1 >= 0.f;
                        if (MODE == MD_WIN) { v0 = v0 && d0 < 512.f; v1 = v1 && d1 < 512.f; }
                        if (MODE == MD_SEL) { v0 = v0 && selbit; v1 = v1 && selbit; }
                        s0[e] = v0 ? s0[e] - c.slope2 * d0 : NINF;
                        s1[e] = v1 ? s1[e] - c.slope2 * d1 : NINF;
                    }
                } else {
                    const float a0 = selbit ? -c.slope2 * dbase : NINF;
#pragma unroll
                    for (int e = 0; e < 16; ++e) {
                        s0[e] = fmaf(c.slope2, (float)(PS * (8 * (e >> 2) + (e & 3))), s0[e] + a0);
                        s1[e] = fmaf(c.slope2, (float)(PS * (32 + 8 * (e >> 2) + (e & 3))), s1[e] + a0);
                    }
                }
            }
            if (MODE != MD_CMP2) {
                float mx = s0[0];
#pragma unroll
                for (int e = 1; e < 16; ++e) mx = fmaxf(mx, s0[e]);
#pragma unroll
                for (int e = 0; e < 16; ++e) mx = fmaxf(mx, s1[e]);
                { typedef unsigned u2_t __attribute__((ext_vector_type(2)));
                  const unsigned mb = __builtin_bit_cast(unsigned, mx);
                  const u2_t sw = __builtin_amdgcn_permlane32_swap(mb, mb, false, false);
                  mx = fmaxf(__builtin_bit_cast(float, sw.x), __builtin_bit_cast(float, sw.y)); }
                const bool need = mx > c.m + 8.0f;
                if (__ballot(need) != 0ull) {
                    const float mnew = need ? mx : c.m;
                    const float alpha = fexp2(c.m - ((mnew == NINF) ? 0.f : mnew));
                    c.l *= alpha; c.m = mnew;
                    if (MODE != MD_CMP1) {
#pragma unroll
                        for (int db = 0; db < 4; ++db)
#pragma unroll
                            for (int e = 0; e < 16; ++e) o[db][e] *= alpha;
                    }
                }
            }
}
template <int MODE> DI void attn_h2(AttnCtx& c, f32x16 (&o)[4], f32x16& s0, f32x16& s1, ldsp lds, int vbuf, int tj, int lane) {
    const int r32 = lane & 31, h = lane >> 5;
    const float NINF = -__builtin_inff();
            if (MODE == MD_CMP2) {
#pragma unroll
                for (int e = 0; e < 16; ++e) { s0[e] = fexp2(s0[e] - c.m) * c.l; s1[e] = fexp2(s1[e] - c.m) * c.l; }
                LAS float* impg = (LAS float*)(lds + A_IMPG) + c.qi * 128; LAS float* imp3 = (LAS float*)(lds + A_IMP3) + c.qi * 128;
#pragma unroll
                for (int kb = 0; kb < 2; ++kb)
#pragma unroll
                    for (int g4 = 0; g4 < 4; ++g4) {
                        float G, p3;
                        if (kb == 0) { G = (s0[4 * g4] + s0[4 * g4 + 1]) + (s0[4 * g4 + 2] + s0[4 * g4 + 3]); p3 = s0[4 * g4 + 3]; }
                        else { G = (s1[4 * g4] + s1[4 * g4 + 1]) + (s1[4 * g4 + 2] + s1[4 * g4 + 3]); p3 = s1[4 * g4 + 3]; }
                        G += shx(G, 1, lane); G += shx(G, 2, lane); p3 += shx(p3, 1, lane); p3 += shx(p3, 2, lane);
                        const int n4 = tj * 16 + kb * 8 + 2 * g4 + h;
                        if ((lane & 3) == 0) { impg[n4] = G; if (n4 + 1 < 128) imp3[n4 + 1] = p3; }
                    }
            } else {
                const float muse = (c.m == NINF) ? 0.f : c.m;
                float ps = 0.f;
#pragma unroll
                for (int e = 0; e < 16; ++e) { s0[e] = fexp2(s0[e] - muse); s1[e] = fexp2(s1[e] - muse); ps += s0[e] + s1[e]; }
                c.l += ps;
                        }
            if (MODE != MD_CMP1) {
                ldsp vl = lds + vbuf + r32 * VPITCH + 16 * h;
#pragma unroll
                for (int kb = 0; kb < 2; ++kb)
#pragma unroll
                    for (int s2 = 0; s2 < 2; ++s2) {
                        u32x4 pw;
                        if (kb == 0) { pw.x = pk2(s0[8 * s2], s0[8 * s2 + 1]); pw.y = pk2(s0[8 * s2 + 2], s0[8 * s2 + 3]); pw.z = pk2(s0[8 * s2 + 4], s0[8 * s2 + 5]); pw.w = pk2(s0[8 * s2 + 6], s0[8 * s2 + 7]); }
                        else { pw.x = pk2(s1[8 * s2], s1[8 * s2 + 1]); pw.y = pk2(s1[8 * s2 + 2], s1[8 * s2 + 3]); pw.z = pk2(s1[8 * s2 + 4], s1[8 * s2 + 5]); pw.w = pk2(s1[8 * s2 + 6], s1[8 * s2 + 7]); }
                        const bf16x8 pf = __builtin_bit_cast(bf16x8, pw);
#pragma unroll
                        for (int db = 0; db < 4; ++db) {
                            const bf16x8 vf = *(const LAS bf16x8*)(vl + db * 32 * VPITCH + (kb * 2 + s2) * 32);
                            o[db] = MFMA32(vf, pf, o[db]);
                        }
                    }
            }
        }
template <int MODE> DI void attn_run(AttnCtx& c, const bf16x8 (&q)[8], f32x16 (&o)[4], ldsp lds, int tid, int wv) {
    constexpr bool STAG = (MODE == MD_FOX);
    const int lane = tid & 63;
    const bool grpB = STAG && (wv >= 4);
    const LAS int* list = (const LAS int*)(lds + A_LIST);
    if (c.ntiles <= 0) return;
    TileRegs tr;
#define TILE_ID(i) ((MODE == MD_SEL) ? list[(i)] : c.tile0 + c.ntiles - 1 - (i))
#define VBUF(m3) (STAG ? ((m3) == 2 ? A_IMPG : A_V + (m3) * TILEV) : A_V + (m3) * TILEV)
    { const int tj = TILE_ID(0);
      tile_gload<MODE>(tr, c.kmat + (size_t)tj * 64 * HD, c.vtm + (size_t)tj * 8192, c.vpitch, c.cumb + (size_t)tj * 64, tid);
      tile_swrite<MODE>(tr, lds, A_K, VBUF(0), 0, tid); }
    __syncthreads();
    f32x16 s0, s1;
    bool dprev = false; int tjprev = 0, m3 = 0, m3prev = 0;
    volatile LAS unsigned* xflag = (volatile LAS unsigned*)(lds + A_LIST + 768);
    bool wneed = true;
    for (int i = 0; i < c.ntiles; ++i) {
        const int cur = i & 1, tj = TILE_ID(i);
        const int m3n = STAG ? (m3 == 2 ? 0 : m3 + 1) : (m3 ^ 1);
        float cb_next = 0.f;
        if (MODE == MD_FOX || ((MODE == MD_SEL || MODE == MD_CMP1 || MODE == MD_CMP2) && c.xsel)) {
            if (i > 0) {
                unsigned any = 0u;
#pragma unroll
                for (int k = 0; k < NWAVES; ++k) any |= xflag[((i - 1) & 1) * NWAVES + k];
                if (any == 0u) break;
            }
            if (MODE == MD_FOX) { if (i + 1 < c.ntiles) cb_next = c.cumb[(size_t)TILE_ID(i + 1) * 64 + 63]; }
            else if (MODE == MD_SEL) { if (i + 1 < c.ntiles) cb_next = -c.slope2 * (float)(c.t - (TILE_ID(i + 1) * 64 + 63)); }
            else { if (i + 1 < c.ntiles) cb_next = -c.slope2 * (float)(c.t - (TILE_ID(i + 1) * 1024 + 1039)); }
        }
        if (i + 1 < c.ntiles) { const int tn = TILE_ID(i + 1);
            tile_gload<MODE>(tr, c.kmat + (size_t)tn * 64 * HD, c.vtm + (size_t)tn * 8192, c.vpitch, c.cumb + (size_t)tn * 64, tid); }
        if (STAG) { if (grpB && dprev) attn_h2<MODE>(c, o, s0, s1, lds, VBUF(m3prev), tjprev, lane); }
        bool doit = (tj <= c.whi) && wneed;
        if (MODE == MD_SEL) doit = wneed && (((tj < 64 ? (c.wun_lo >> tj) : (c.wun_hi >> (tj - 64))) & 1ull) != 0ull);
        if (doit) attn_h1<MODE>(c, q, o, s0, s1, lds, A_K + cur * TILEB, cur * 256, tj, lane);
        if (!grpB && doit) attn_h2<MODE>(c, o, s0, s1, lds, VBUF(m3), tj, lane);
        dprev = doit; tjprev = tj; m3prev = m3;
        if (i + 1 < c.ntiles) tile_swrite<MODE>(tr, lds, A_K + (cur ^ 1) * TILEB, VBUF(m3n), (cur ^ 1) * 256, tid);
        m3 = m3n;
        if (MODE == MD_FOX || ((MODE == MD_SEL || MODE == MD_CMP1 || MODE == MD_CMP2) && c.xsel)) {
            const bool needs = (cb_next + c.bqk >= c.m - 32.0f);
            const unsigned wn = (__ballot(needs) != 0ull) ? 1u : 0u;
            wneed = (wn != 0u);
            if (lane == 0) xflag[(i & 1) * NWAVES + wv] = wn;
        }
        __syncthreads();
    }
    if (STAG) { if (grpB && dprev) attn_h2<MODE>(c, o, s0, s1, lds, VBUF(m3prev), tjprev, lane); __syncthreads(); }
#undef VBUF
#undef TILE_ID
}
DI void load_q(bf16x8 (&q)[8], const bf16* qrow, int h, const float* gain, int lane) {
    float ss = 0.f;
#pragma unroll
    for (int s = 0; s < 8; ++s) { const u32x4 raw = *(const u32x4*)(qrow + 16 * s + 8 * h);
#pragma unroll
        for (int j = 0; j < 4; ++j) { const float a = __builtin_bit_cast(float, raw[j] << 16), b = __builtin_bit_cast(float, raw[j] & 0xffff0000u); ss += a * a + b * b; } }
    ss += shx(ss, 32, lane);
    const float rs = rsqrtf(ss * (1.0f / HD) + EPS) * C2;
    asm volatile("" ::: "memory");
#pragma unroll
    for (int s = 0; s < 8; ++s) {
        const u32x4 raw = *(const u32x4*)(qrow + 16 * s + 8 * h);
        const f32x4 g0 = *(const f32x4*)(gain + 16 * s + 8 * h), g1 = *(const f32x4*)(gain + 16 * s + 8 * h + 4);
        u32x4 w;
        w.x = pk2(__builtin_bit_cast(float, raw.x << 16) * rs * g0[0], __builtin_bit_cast(float, raw.x & 0xffff0000u) * rs * g0[1]);
        w.y = pk2(__builtin_bit_cast(float, raw.y << 16) * rs * g0[2], __builtin_bit_cast(float, raw.y & 0xffff0000u) * rs * g0[3]);
        w.z = pk2(__builtin_bit_cast(float, raw.z << 16) * rs * g1[0], __builtin_bit_cast(float, raw.z & 0xffff0000u) * rs * g1[1]);
        w.w = pk2(__builtin_bit_cast(float, raw.w << 16) * rs * g1[2], __builtin_bit_cast(float, raw.w & 0xffff0000u) * rs * g1[3]);
        q[s] = __builtin_bit_cast(bf16x8, w);
    }
}
DI void zero_o(f32x16 (&o)[4]) {
#pragma unroll
    for (int db = 0; db < 4; ++db)
#pragma unroll
        for (int e = 0; e < 16; ++e) o[db][e] = 0.f;
}
DI void fox_unit(const P& p, ldsp lds, int u, int l, int wv) {
    const int tid = tid_of(wv), lane = tid & 63, w = tid >> 6, r32 = lane & 31, h = lane >> 5;
    const int qb = 31 - (u >> 4), bh = u & 15, b = bh >> 3, hd = bh & 7;
    const bf16* heads = (const bf16*)(p.ws + WS_HEADS); const bf16* VT = (const bf16*)(p.ws + WS_VT);
    const int t = qb * 256 + w * 32 + r32;
    bf16x8 q[8]; load_q(q, heads + ((size_t)hd * M + b * T + t) * HD, h, p.fqn + l * HD, lane);
    f32x16 o[4]; zero_o(o);
    AttnCtx c;
    c.kmat = heads + ((size_t)(8 + hd) * M + b * T) * HD; c.vtm = VT + ((size_t)hd * (M / 64) + b * (T / 64)) * 8192; c.vpitch = 64;
    c.cumb = (const float*)(p.ws + WS_CUMB) + (size_t)bh * T;
    int tstart;
    { const float* fq = p.fqn + l * HD; const float* fk = p.fkn + l * HD;
      float gq = fmaxf(fabsf(fq[lane]), fabsf(fq[lane + 64])), gk = fmaxf(fabsf(fk[lane]), fabsf(fk[lane + 64]));
#pragma unroll
      for (int o2 = 1; o2 < 64; o2 <<= 1) { gq = fmaxf(gq, shx(gq, o2, lane)); gk = fmaxf(gk, shx(gk, o2, lane)); }
      const float BQK = 1.02f * C2 * 128.0f * gq * gk;
      c.bqk = BQK; c.xsel = false;
      const float thr = c.cumb[qb * 256] - 2.0f * BQK - 32.0f;
      const int nt = 4 * qb + 4;
      const bool skip0 = (lane < nt) && (c.cumb[lane * 64 + 63] < thr);
      const bool skip1 = (lane + 64 < nt) && (c.cumb[(lane + 64) * 64 + 63] < thr);
      tstart = __popcll(__ballot(skip0)) + __popcll(__ballot(skip1)); }
    c.ntiles = 4 * qb + 4 - tstart; c.tile0 = tstart; c.mtile = 0; c.t = t; c.slope2 = 0.f; c.whi = 4 * qb + (w >> 1); c.wun_lo = 0; c.wun_hi = 0;
    c.m = -__builtin_inff(); c.l = 0.f; c.qi = 0;
    attn_run<MD_FOX>(c, q, o, lds, tid, wv);
    const float lt = c.l + shx(c.l, 32, lane); const float inv = lt > 0.f ? 1.0f / lt : 0.f;
    bf16* orow = (bf16*)(p.ws + WS_OMIX) + (size_t)(b * T + t) * DM + hd * HD + 4 * h;
#pragma unroll
    for (int db = 0; db < 4; ++db)
#pragma unroll
        for (int g4 = 0; g4 < 4; ++g4) {
            u32x2 wv; wv.x = pk2(o[db][4 * g4] * inv, o[db][4 * g4 + 1] * inv); wv.y = pk2(o[db][4 * g4 + 2] * inv, o[db][4 * g4 + 3] * inv);
            *(u32x2*)(orow + 32 * db + 8 * g4) = wv;
        }
}
DI float sigmoidf_(float x) { return 1.0f / (1.0f + __expf(-x)); }
template <int STEP> DI void nsa_store(const f32x16 (&o)[4], float sc, ldsp acc, bf16* orow) {
#pragma unroll
    for (int db = 0; db < 4; ++db)
#pragma unroll
        for (int g4 = 0; g4 < 4; ++g4) {
            f32x4 v; v[0] = o[db][4 * g4] * sc; v[1] = o[db][4 * g4 + 1] * sc; v[2] = o[db][4 * g4 + 2] * sc; v[3] = o[db][4 * g4 + 3] * sc;
            ldsp a = acc + (db * 4 + g4) * 512;
            if (STEP >= 1) { const u32x2 r = *(const LAS u32x2*)a;
                v[0] += __builtin_bit_cast(float, r.x << 16); v[1] += __builtin_bit_cast(float, r.x & 0xffff0000u); v[2] += __builtin_bit_cast(float, r.y << 16); v[3] += __builtin_bit_cast(float, r.y & 0xffff0000u); }
            u32x2 wv; wv.x = pk2(v[0], v[1]); wv.y = pk2(v[2], v[3]);
            if (STEP <= 1) *(LAS u32x2*)a = wv; else *(u32x2*)(orow + 32 * db + 8 * g4) = wv;
        }
}
DI void nsa_unit(const P& p, ldsp lds, int u, int l, int wv) {
    const int tid = tid_of(wv), lane = tid & 63, w = tid >> 6, r32 = lane & 31, h = lane >> 5;
    const int qb = 127 - (u >> 2), bg = u & 3, b = bg >> 1, g = bg & 1;
    const bf16* heads = (const bf16*)(p.ws + WS_HEADS); const bf16* VT = (const bf16*)(p.ws + WS_VT);
    const int ql = r32 >> 2, r = r32 & 3, qi = w * 8 + ql, t = qb * 64 + qi, hn = g * 4 + r;
#pragma unroll
    for (int k = 0; k < 8; ++k) *(LAS f32x4*)(lds + A_IMPG + (k * 512 + tid) * 16) = (f32x4){0.f, 0.f, 0.f, 0.f};
    bf16x8 q[8]; load_q(q, heads + ((size_t)(16 + hn) * M + b * T + t) * HD, h, p.nqn + l * HD, lane);
#define NSA_GATE(k) sigmoidf_(((const float*)(p.ws + WS_SCAL))[(size_t)(b * T + t) * 32 + 8 + hn * 3 + (k)])
#define NSA_OACC (lds + A_IMPG + w * 8192 + lane * 8)
#define NSA_OROW ((bf16*)(p.ws + WS_OMIX) + (size_t)(b * T + t) * DM + 1024 + hn * HD + 4 * h)
    f32x16 o[4]; zero_o(o);
    AttnCtx c;
    c.bqk = 0.f; c.xsel = (g == 0);
    if (g == 0) { const float* fq = p.nqn + l * HD; const float* fk = p.skn + l * HD; const float* fc = p.ckn + l * HD;
      float gq = fmaxf(fabsf(fq[lane]), fabsf(fq[lane + 64])), gk = fmaxf(fmaxf(fabsf(fk[lane]), fabsf(fk[lane + 64])), fmaxf(fabsf(fc[lane]), fabsf(fc[lane + 64])));
#pragma unroll
      for (int o2 = 1; o2 < 64; o2 <<= 1) { gq = fmaxf(gq, shx(gq, o2, lane)); gk = fmaxf(gk, shx(gk, o2, lane)); }
      c.bqk = 1.02f * C2 * 128.0f * gq * gk; }
    c.t = t; c.mtile = qb; c.slope2 = LOG2E * exp2f(-(float)(hn + 1)); c.wun_lo = 0; c.wun_hi = 0; c.qi = qi; c.cumb = (const float*)(p.ws + WS_CUMB);
    const float NINF = -__builtin_inff();
    c.kmat = (const bf16*)(p.ws + WS_KCMP) + (size_t)(g * 1024 + b * 512) * HD; c.vtm = (const bf16*)(p.ws + WS_VCT) + (size_t)((g * 1024 + b * 512) / 64) * 8192; c.vpitch = 64;
    c.ntiles = (4 * qb + 2) / 64 + 1; c.tile0 = 0; c.whi = 1 << 30; c.m = NINF; c.l = 0.f;
    attn_run<MD_CMP1>(c, q, o, lds, tid, wv);
    { const float lt = c.l + shx(c.l, 32, lane); c.l = lt > 0.f ? 1.0f / lt : 0.f; c.m = (c.m == NINF) ? 0.f : c.m; }
    attn_run<MD_CMP2>(c, q, o, lds, tid, wv);
    {
        u64 wlo = 0, whi2 = 0;
        for (int k = 0; k < 8; ++k) {
            const int qq = w * 8 + k, tq = qb * 64 + qq;
            LAS float* ig = (LAS float*)(lds + A_IMPG) + qq * 128; const LAS float* i3 = (const LAS float*)(lds + A_IMP3) + qq * 128;
            const int j0 = lane, j1 = lane + 64;
            const bool f0 = (j0 == 0) | (j0 == qb) | (j0 == qb - 1), f1 = (j1 == qb) | (j1 == qb - 1);
            const bool va0 = j0 * 64 <= tq, va1 = j1 * 64 <= tq;
            const float v0 = f0 ? 1e9f : (va0 ? ig[j0] + i3[j0] : -1e9f), v1 = f1 ? 1e9f : (va1 ? ig[j1] + i3[j1] : -1e9f);
            const unsigned b0 = __builtin_bit_cast(unsigned, v0), b1 = __builtin_bit_cast(unsigned, v1);
            const unsigned k0 = b0 ^ ((b0 >> 31) ? 0xFFFFFFFFu : 0x80000000u), k1 = b1 ^ ((b1 >> 31) ? 0xFFFFFFFFu : 0x80000000u);
            unsigned th = 0u;
#pragma unroll 4
            for (int bit = 31; bit >= 0; --bit) {
                const unsigned trial = th | (1u << bit);
                const int cnt = __popcll(__ballot(k0 >= trial)) + __popcll(__ballot(k1 >= trial));
                th = (cnt >= 16) ? trial : th;
            }
            const u64 gt0 = __ballot(k0 > th), gt1 = __ballot(k1 > th), eq0 = __ballot(k0 == th), eq1 = __ballot(k1 == th);
            const int need = 16 - (__popcll(gt0) + __popcll(gt1));
            const u64 below = (lane == 0) ? 0ull : (~0ull >> (64 - lane));
            const int pos0 = __popcll(eq0 & below), pos1 = __popcll(eq0) + __popcll(eq1 & below);
            const bool s0 = (k0 > th) || (k0 == th && pos0 < need), s1 = (k1 > th) || (k1 == th && pos1 < need);
            const u64 lo = __ballot(s0 && va0), hi = __ballot(s1 && va1);
            if (lane == 0) { *(LAS u64*)(lds + A_SEL + qq * 16) = lo; *(LAS u64*)(lds + A_SEL + qq * 16 + 8) = hi; }
            wlo |= lo; whi2 |= hi;
        }
        if (lane == 0) { *(LAS u64*)(lds + A_WUN + w * 16) = wlo; *(LAS u64*)(lds + A_WUN + w * 16 + 8) = whi2; }
        c.wun_lo = wlo; c.wun_hi = whi2;
        __syncthreads();
        if (tid == 0) {
            u64 ulo = 0, uhi = 0;
            for (int k = 0; k < 8; ++k) { ulo |= *(LAS u64*)(lds + A_WUN + k * 16); uhi |= *(LAS u64*)(lds + A_WUN + k * 16 + 8); }
            LAS int* list = (LAS int*)(lds + A_LIST); int cnt = 0;
            for (int j = 63; j >= 0; --j) if ((uhi >> j) & 1ull) list[cnt++] = 64 + j;
            for (int j = 63; j >= 0; --j) if ((ulo >> j) & 1ull) list[cnt++] = j;
            list[128] = cnt;
        }
        __syncthreads();
        c.ntiles = ((LAS int*)(lds + A_LIST))[128];
    }
    nsa_store<0>(o, NSA_GATE(0), NSA_OACC, NSA_OROW);
    zero_o(o); c.m = NINF; c.l = 0.f; c.tile0 = 0; c.whi = 1 << 30;
    c.kmat = heads + ((size_t)(28 + g) * M + b * T) * HD; c.vtm = VT + ((size_t)(8 + g) * (M / 64) + b * (T / 64)) * 8192; c.vpitch = 64;
    attn_run<MD_SEL>(c, q, o, lds, tid, wv);
    { const float lt = c.l + shx(c.l, 32, lane); nsa_store<1>(o, lt > 0.f ? NSA_GATE(1) / lt : 0.f, NSA_OACC, NSA_OROW); }
    zero_o(o); c.m = NINF; c.l = 0.f; c.tile0 = qb >= 8 ? qb - 8 : 0; c.ntiles = qb - c.tile0 + 1; c.whi = 1 << 30;
    c.kmat = heads + ((size_t)(30 + g) * M + b * T) * HD; c.vtm = VT + ((size_t)(10 + g) * (M / 64) + b * (T / 64)) * 8192;
    attn_run<MD_WIN>(c, q, o, lds, tid, wv);
    { const float lt = c.l + shx(c.l, 32, lane); nsa_store<2>(o, lt > 0.f ? NSA_GATE(2) / lt : 0.f, NSA_OACC, NSA_OROW); }
    __syncthreads();
}
#define XB_TMO      128
#define XB_XCNT(j)  (256  + 64 * (j))
#define XB_XSUB(j)  (1280 + 64 * (j))
#define XB_XGEN(j)  (2304 + 64 * (j))
#define XB_TOP      3328
#define XB_TOPGEN   3392
#define XCD_BAR_WORDS 3456
#define XB_SPIN_CAP (1u << 18)

__device__ __forceinline__ unsigned xb_ld(unsigned* p)              { return __hip_atomic_load(p, __ATOMIC_RELAXED, __HIP_MEMORY_SCOPE_AGENT); }
__device__ __forceinline__ unsigned xb_add(unsigned* p, unsigned v) { return __hip_atomic_fetch_add(p, v, __ATOMIC_RELAXED, __HIP_MEMORY_SCOPE_AGENT); }
__device__ __forceinline__ unsigned xb_xcc_id() { return (unsigned)__builtin_amdgcn_s_getreg((3 << 11) | 20) & 0xFu; }
#define XB_SPIN(cond, bar) do { unsigned _sp = 0; while (cond) { __builtin_amdgcn_s_sleep(1); \
    if ((++_sp & 255u) == 0u) { if (xb_ld(&(bar)[XB_TMO])) break; if (_sp > XB_SPIN_CAP) { atomicAdd(&(bar)[XB_TMO], 1u); break; } } } } while (0)

struct XcdBarrier {
    unsigned* bar; unsigned x;
    volatile LAS unsigned* st;
};

__device__ __forceinline__ XcdBarrier xcd_barrier_post(unsigned* bar, volatile LAS unsigned* st, bool leader) {
    XcdBarrier b; b.bar = bar; b.x = xb_xcc_id(); b.st = st;
    if (leader) (void)xb_add(&bar[XB_XCNT(b.x)], 1u);
    return b;
}
__device__ __forceinline__ void xcd_barrier_complete(unsigned* bar, unsigned x, unsigned& nloc, unsigned& nx) {
    const unsigned G = gridDim.x * gridDim.y * gridDim.z;
    unsigned sum, cnt, mine, sp = 0u;
    for (;;) {
        sum = 0u; cnt = 0u; mine = 0u;
#pragma unroll
        for (unsigned j = 0; j < 16; ++j) { const unsigned c = xb_ld(&bar[XB_XCNT(j)]); sum += c; cnt += (c > 0u) ? 1u : 0u; mine = (j == x) ? c : mine; }
        if (sum == G) break;
        __builtin_amdgcn_s_sleep(1);
        if ((++sp & 255u) == 0u) { if (xb_ld(&bar[XB_TMO])) break; if (sp > XB_SPIN_CAP) { atomicAdd(&bar[XB_TMO], 1u); break; } }
    }
    nloc = mine > 0u ? mine : 1u; nx = cnt > 0u ? cnt : 1u;
}

__device__ __forceinline__ void xcd_barrier(const XcdBarrier& b, bool leader) {
    asm volatile("s_waitcnt vmcnt(0)" ::: "memory");
    __syncthreads();
    if (leader) {
        unsigned* bar = b.bar;
        __builtin_amdgcn_s_waitcnt(0);
        unsigned nloc = b.st[0], nx = b.st[1];
        if (nloc == 0u) { xcd_barrier_complete(bar, b.x, nloc, nx); b.st[0] = nloc; b.st[1] = nx; }
        const unsigned old = xb_add(&bar[XB_XSUB(b.x)], 1u);
        const unsigned gen = old / nloc;
        if (old + 1u == (gen + 1u) * nloc) {
            __builtin_amdgcn_fence(__ATOMIC_RELEASE, "agent");
            asm volatile("s_waitcnt vmcnt(0)" ::: "memory");
            const unsigned og = xb_add(&bar[XB_TOP], 1u);
            const unsigned tg = og / nx;
            if (og + 1u == (tg + 1u) * nx) xb_add(&bar[XB_TOPGEN], 1u);
            else XB_SPIN(xb_ld(&bar[XB_TOPGEN]) == tg, bar);
            __builtin_amdgcn_fence(__ATOMIC_ACQUIRE, "agent");
            xb_add(&bar[XB_XGEN(b.x)], 1u);
            asm volatile("s_waitcnt vmcnt(0)" ::: "memory");
        } else {
            XB_SPIN(xb_ld(&bar[XB_XGEN(b.x)]) == gen, bar);
            __builtin_amdgcn_fence(__ATOMIC_ACQUIRE, "agent");
            asm volatile("s_waitcnt vmcnt(0)" ::: "memory");
        }
    }
    __syncthreads();
}

__global__ void __launch_bounds__(NTHR, 2) hybrid_fwd(P p) {
    extern __shared__ __attribute__((aligned(16))) unsigned char lds_raw[];
    ldsp lds = (ldsp)lds_raw;
    cg::grid_group grid = cg::this_grid();
    const int G0 = gridDim.x;

#ifndef PHMASK
#define PHMASK 0xFFFF
#endif
#define PH(k) ((PHMASK >> (k)) & 1)
    const int wv = __builtin_amdgcn_readfirstlane((int)threadIdx.x >> 6);
    volatile LAS unsigned* bst = (volatile LAS unsigned*)(lds + LDS_BYTES - 64);
    if (threadIdx.x < 2) bst[threadIdx.x] = 0u;
    __syncthreads();
    XcdBarrier bar = xcd_barrier_post((unsigned*)(p.ws + WS_BAR), bst, threadIdx.x == 0);
#define SEAM() xcd_barrier(bar, wv == 0 && tid_of(wv) == 0)
    if (PH(0)) prologue(p, lds, G0, wv);
    grid.sync();

#pragma unroll
    for (int l = 0; l < 2; ++l) {
        const int tid = tid_of(wv);
        int G = gridDim.x, c = blockIdx.x; asm volatile("" : "+s"(G), "+s"(c));
        unsigned char* ws = p.ws; asm volatile("" : "+s"(ws));
        bf16* XB = (bf16*)(ws + WS_XB); bf16* HEADS = (bf16*)(ws + WS_HEADS); bf16* VT = (bf16*)(ws + WS_VT); bf16* HB = (bf16*)(ws + WS_H); bf16* OMIX = (bf16*)(ws + WS_OMIX);
        float* SCAL = (float*)(ws + WS_SCAL); float* SS = (float*)(ws + WS_SS); float* PB = (float*)(ws + WS_PB);
        unsigned char* wl = ws + (size_t)l * WL;
        const float* ssA = SS + (size_t)(2 * l) * M; float* ssF = SS + (size_t)(2 * l + 1) * M; float* ssN = (l == 0) ? SS + (size_t)2 * M : nullptr;
        if (PH(1)) { pg8::Gemm g{XB, (const bf16*)(wl + OW1), M, N1, DM, DM, DM, (const bf16*)(wl + OW2), XB}; MergedOrder S; S.init(G, c);
          EpiInProj E{{HEADS, SCAL, ssA}, {VT, ssA}};
          pg8::gemm_phase<EpiInProj, MergedOrder, true, true>(lds, g, S, E, wv); }
        SEAM();
        if (PH(3) && (c < 16 || c >= 48)) post_norm(p, l, G - 32, c < 16 ? c : c - 32, wv);
        if (c >= 48) {
            convert_weights(p, lds, l, 1, G - 48, c - 48, wv);
            if (l == 0) convert_weights(p, lds, 1, 0, G - 48, c - 48, wv);
        }
        if (PH(4) && c < 16) post_cumsum(p, l, lds, c, wv);
        else if (PH(5) && c >= 16 && c < 48) {
            const int cu = c - 16, isv = cu >> 4, unit = (cu & 15) >> 1, half = cu & 1;
            float* kraw = (float*)(ws + WS_KRAW2); float* vraw = (float*)(ws + WS_VRAW2);
            const bf16* spans = HEADS + (size_t)(isv ? 26 : 24) * M * HD + half * 2048;
            const bf16* wct = (const bf16*)(wl + OWC) + half * 2048;
            if (!isv) { pg8::Gemm g{spans, wct, 2048, 256, 2048, 2048, 4096}; OneUnit S{true, {unit, 0}};
                EpiCmpK E{kraw + (size_t)half * 2048 * 128};
                pg8::gemm_phase<EpiCmpK, OneUnit, false, true>(lds, g, S, E, wv); }
            else { pg8::Gemm g{wct, spans, 256, 2048, 2048, 4096, 2048}; OneUnit S{true, {0, unit}};
                EpiCmpVraw E{vraw + (size_t)half * 128 * 2048};
                pg8::gemm_phase<EpiCmpVraw, OneUnit, false, true>(lds, g, S, E, wv); }
            __builtin_amdgcn_fence(__ATOMIC_RELEASE, "agent");
            __syncthreads();
            volatile LAS unsigned* cslot = (volatile LAS unsigned*)(lds + LDS_BYTES - 32);
            if (tid == 0) *cslot = __hip_atomic_fetch_add((unsigned*)(ws + WS_CCTR) + l * 16 + isv * 8 + unit, 1u, __ATOMIC_RELAXED, __HIP_MEMORY_SCOPE_AGENT);
            __syncthreads();
            if (*cslot == 1u) {
                __builtin_amdgcn_fence(__ATOMIC_ACQUIRE, "agent");
                const int lane = tid & 63, wave = tid >> 6, sub = lane & 15;
                if (!isv) {
                    const float* pbk = PB + (l * 2 + 0) * 128 + sub * 8; const float* gp = p.ckn + l * HD + sub * 8;
                    bf16* kcmp = (bf16*)(ws + WS_KCMP);
                    for (int it = wave; it < 64; it += NWAVES) {
                        const int row = unit * 256 + it * 4 + (lane >> 4);
                        const float* src = kraw + (size_t)row * HD + sub * 8;
                        float v[8]; float sq = 0.f;
#pragma unroll
                        for (int j = 0; j < 8; ++j) { v[j] = src[j] + src[2048 * 128 + j] + pbk[j]; sq += v[j] * v[j]; }
                        sq += shx(sq, 1, lane); sq += shx(sq, 2, lane); sq += shx(sq, 4, lane); sq += shx(sq, 8, lane);
                        const float rs = rsqrtf(sq * (1.0f / HD) + EPS);
                        u32x4 ov; ov.x = pk2(v[0] * rs * gp[0], v[1] * rs * gp[1]); ov.y = pk2(v[2] * rs * gp[2], v[3] * rs * gp[3]);
                        ov.z = pk2(v[4] * rs * gp[4], v[5] * rs * gp[5]); ov.w = pk2(v[6] * rs * gp[6], v[7] * rs * gp[7]);
                        *(u32x4*)(kcmp + (size_t)row * HD + sub * 8) = ov;
                    }
                } else {
                    const float* pbv = PB + (l * 2 + 1) * 128; bf16* vct = (bf16*)(ws + WS_VCT);
                    for (int it = tid; it < 128 * 32; it += NTHR) {
                        const int e = it >> 5, R = unit * 256 + (it & 31) * 8;
                        const float* src = vraw + (size_t)e * 2048 + R; const float pb = pbv[e];
                        const f32x4 a0 = *(const f32x4*)src + *(const f32x4*)(src + 128 * 2048) + pb, a1 = *(const f32x4*)(src + 4) + *(const f32x4*)(src + 128 * 2048 + 4) + pb;
                        u32x4 ov; ov.x = pk2(a0[0], a0[1]); ov.y = pk2(a0[2], a0[3]); ov.z = pk2(a1[0], a1[1]); ov.w = pk2(a1[2], a1[3]);
                        *(u32x4*)(vct + ((size_t)(R >> 6) * 128 + e) * 64 + (R & 63)) = ov;
                    }
                }
            }
            __syncthreads();
        }
        SEAM();
        for (int i = c; i < 256; i += G) {
            if (PH(7)) fox_unit(p, lds, i, l, wv);
            if (PH(8)) nsa_unit(p, lds, i, l, wv);
            if (PH(8)) nsa_unit(p, lds, 511 - i, l, wv);
            if (PH(7)) fox_unit(p, lds, 511 - i, l, wv);
        }
        SEAM();
        if (PH(9)) { pg8::Gemm g{OMIX, (const bf16*)(wl + OWO), M, DM, DM, DM, DM}; pg8::StaticOrder S; S.init(M, DM, G, c);
          EpiRes E{nullptr, XB, ssF, lds + 131072};
          pg8::gemm_phase<EpiRes, pg8::StaticOrder, true, true>(lds, g, S, E, wv); }
        SEAM();
        if (PH(10)) { pg8::Gemm g{XB, (const bf16*)(wl + OWGU), M, NGU, DM, DM, DM}; pg8::StaticOrder S; S.init(M, NGU, G, c);
          EpiGU E{HB, ssF};
          pg8::gemm_phase<EpiGU, pg8::StaticOrder, true, true>(lds, g, S, E, wv); }
        SEAM();
        if (PH(11)) { pg8::Gemm g{HB, (const bf16*)(wl + OWD), M, DM, FF, FF, FF}; pg8::StaticOrder S; S.init(M, DM, G, c);
          EpiRes E{l == 1 ? p.out : nullptr, XB, ssN, lds + 131072};
          pg8::gemm_phase<EpiRes, pg8::StaticOrder, true, true>(lds, g, S, E, wv); }
        if (l == 0) SEAM();
    }
}

extern "C" void kernel_launch(void* const* d_in, const int* in_sizes, int n_in, void* d_out, int out_size, void* d_ws, size_t ws_size, hipStream_t stream) {
    static int grid_blocks = 0;
    if (grid_blocks == 0) {
        if (n_in != 19 || ws_size < WS_END) { fprintf(stderr, "kernel_launch: unexpected n_in %d / ws_size %zu (need %zu)\n", n_in, ws_size, (size_t)WS_END); grid_blocks = -1; return; }
        int dev = 0, cus = 0, per_cu = 0;
        hipGetDevice(&dev); hipDeviceGetAttribute(&cus, hipDeviceAttributeMultiprocessorCount, dev);
        if (hipFuncSetAttribute((const void*)hybrid_fwd, hipFuncAttributeMaxDynamicSharedMemorySize, LDS_BYTES) != hipSuccess) fprintf(stderr, "kernel_launch: hipFuncSetAttribute failed\n");
        if (hipOccupancyMaxActiveBlocksPerMultiprocessor(&per_cu, (const void*)hybrid_fwd, NTHR, LDS_BYTES) != hipSuccess || per_cu < 1) { fprintf(stderr, "kernel_launch: occupancy query says %d\n", per_cu); per_cu = 1; }
        (void)hipGetLastError();
        grid_blocks = cus;
        if (grid_blocks < 64) { fprintf(stderr, "kernel_launch: too few CUs (%d)\n", grid_blocks); grid_blocks = -1; return; }
    }
    if (grid_blocks < 0) return;
    hipMemsetAsync((char*)d_ws + ZERO_OFF, 0, ZERO_BYTES, stream);
    P p{};
    const float** pp = (const float**)&p;
    for (int i = 0; i < 19; ++i) pp[i] = (const float*)d_in[i];
    p.out = (float*)d_out; p.ws = (unsigned char*)d_ws;
    void* args[] = {&p};
    hipError_t e = hipLaunchCooperativeKernel((const void*)hybrid_fwd, dim3(grid_blocks), dim3(NTHR), args, LDS_BYTES, stream);
    if (e != hipSuccess) fprintf(stderr, "cooperative launch failed: %s (grid %d)\n", hipGetErrorString(e), grid_blocks);
}
```

```cpp
#include <hip/hip_runtime.h>
#include <hip/hip_cooperative_groups.h>
#include <cstdio>
#include <cstdint>
namespace cg = cooperative_groups;
namespace pg8 {
#define PG8_LAS __attribute__((address_space(3)))
typedef unsigned short bf16_t;
typedef short bf16x8 __attribute__((ext_vector_type(8)));
typedef float f32x4 __attribute__((ext_vector_type(4)));
typedef unsigned u32x4 __attribute__((ext_vector_type(4)));
constexpr int BM = 256, BK = 64, HALF = 128, HTB = HALF * BK * 2  , STAGE_BYTES = 8 * HTB, NXCD = 8, WGM = 8;

__host__ __device__ __forceinline__ int lds_byte(int r, int c) { const int st = (r >> 4) * 2 + (c >> 5), rr = r & 15, cc = c & 31, ob = rr * 64 + cc * 2; return st * 1024 + (ob ^ (((ob >> 9) & 1) << 5)); }
__host__ __device__ __forceinline__ void stage_rc(int b, int& R, int& C) { const int st = b / 1024, sb = b % 1024, swz = sb ^ (((sb >> 9) & 1) << 5); R = (st >> 1) * 16 + swz / 64; C = (st & 1) * 32 + (swz % 64) / 2; }
__host__ __device__ __forceinline__ int perm32(int rho) { const int n = rho >> 4, i = rho & 15; return 8 * (i >> 2) + 4 * n + (i & 3); }

struct Unit { int pm, pn, sw; };
struct Gemm { const bf16_t* A; const bf16_t* Bt; int M, N, K, lda, ldb; const bf16_t* A2; const bf16_t* Bt2; };

struct StaticOrder {
    int nM, nN, nwg, G, c;
    __host__ __device__ void init(int M, int N, int G_, int c_) { nM = M / BM; nN = N / BM; nwg = nM * nN; G = G_; c = c_; }
    __host__ __device__ bool next(int i, Unit& u) const {
        const long L = (long)i * G + c; if (L >= nwg) return false;
        int wgid = (int)L; { const int q = nwg / NXCD, r = nwg % NXCD, xcd = wgid % NXCD, off = wgid / NXCD; wgid = (xcd < r ? xcd * (q + 1) : r * (q + 1) + (xcd - r) * q) + off; }
        const int nig = WGM * nN, gid = wgid / nig, fm = gid * WGM, gsz = (nM - fm) < WGM ? (nM - fm) : WGM;
        u.pm = fm + ((wgid % nig) % gsz); u.pn = (wgid % nig) / gsz; u.sw = 0; return true;
    }
    __device__ __forceinline__ void a_ready(const Unit&) const {}
    __device__ __forceinline__ void done(const Unit&) const {}
};


template <class Epi, class Sched, bool ALIGN_EPI = false, bool SP2 = false>
__device__ __forceinline__ void gemm_phase(PG8_LAS unsigned char* lds, const Gemm g, const Sched& S, const Epi& E, int wv) {
    int ln_; asm volatile("v_mbcnt_lo_u32_b32 %0, -1, 0\n\tv_mbcnt_hi_u32_b32 %0, -1, %0" : "=v"(ln_));
    int wid_ = wv; asm volatile("" : "+s"(wid_));
    const int wid = wid_, tid = wid * 64 + ln_, lane = tid & 63, wr = wid >> 2, wc = wid & 3, fr = lane & 15, fq = lane >> 4;
    const int K = g.K, nt = K / BK;
    unsigned voffA[2], voffB[2];
#pragma unroll
    for (int i = 0; i < 2; ++i) { int R, C; stage_rc(tid * 16 + i * 8192, R, C); const int Rb = Epi::PERM ? ((R & ~31) + perm32(R & 31)) : R;
        voffA[i] = (unsigned)(R * g.lda + C) * 2u; voffB[i] = (unsigned)(Rb * g.ldb + C) * 2u; }
    const size_t kstep = (size_t)(BK * 2);
    const size_t hstepA = (size_t)HALF * g.lda * 2, hstepB = (size_t)HALF * g.ldb * 2;
    const size_t tstepA = 2 * hstepA, tstepB = 2 * hstepB;
    const unsigned ldsw = (unsigned)wid * 1024u;
    const int aoff = lds_byte(wr * 64 + fr, fq * 8), boff = lds_byte(wc * 32 + fr, fq * 8);
#define PG8_SA(b, h) (((b) * 2 + (h)) * HTB)
#define PG8_SB(b, h) ((4 + (b) * 2 + (h)) * HTB)
#define PG8_STAGE(bufoff, gbase, voff) do { _Pragma("unroll") for (int _i = 0; _i < 2; ++_i) \
        __builtin_amdgcn_global_load_lds((const unsigned*)((const char*)(gbase) + (voff)[_i]), (PG8_LAS unsigned*)(lds + (bufoff) + ldsw + _i * 8192), 16, 0, 0); } while (0)
#define PG8_LDA(dst, b, h) do { _Pragma("unroll") for (int m = 0; m < 4; ++m) _Pragma("unroll") for (int k = 0; k < 2; ++k) dst[m][k] = *(const PG8_LAS bf16x8*)(lds + PG8_SA(b, h) + aoff + m * 2048 + k * 1024); } while (0)
#define PG8_LDB(dst, b, h) do { _Pragma("unroll") for (int n = 0; n < 2; ++n) _Pragma("unroll") for (int k = 0; k < 2; ++k) dst[n][k] = *(const PG8_LAS bf16x8*)(lds + PG8_SB(b, h) + boff + n * 2048 + k * 1024); } while (0)
#define PG8_MMA(ai, bj, At, Bt) do { __builtin_amdgcn_s_setprio(1); _Pragma("unroll") for (int m = 0; m < 4; ++m) _Pragma("unroll") for (int n = 0; n < 2; ++n) _Pragma("unroll") for (int k = 0; k < 2; ++k) \
        acc[ai][bj][m][n] = __builtin_amdgcn_mfma_f32_16x16x32_bf16(Bt[n][k], At[m][k], acc[ai][bj][m][n], 0, 0, 0); __builtin_amdgcn_s_setprio(0); } while (0)
#define PG8_WAIT_V(n) asm volatile("s_waitcnt vmcnt(" #n ")" ::: "memory")
#define PG8_WAIT_L(n) asm volatile("s_waitcnt lgkmcnt(" #n ")" ::: "memory")
#define PG8_BAR __builtin_amdgcn_s_barrier()
#define PG8_SCHED __builtin_amdgcn_sched_barrier(0)
    Unit cur, nxt; int ui = 0;
    if (!S.next(0, cur)) return;
    f32x4 acc[2][2][4][2];
#pragma unroll
    for (int a = 0; a < 2; ++a)
#pragma unroll
        for (int b = 0; b < 2; ++b)
#pragma unroll
            for (int m = 0; m < 4; ++m)
#pragma unroll
                for (int n = 0; n < 2; ++n) acc[a][b][m][n] = (f32x4){0.f, 0.f, 0.f, 0.f};
    bf16x8 At[4][2], B0[2][2], B1[2][2];
    const char* cA = (const char*)(cur.sw ? g.A2 : g.A) + (size_t)cur.pm * tstepA; const char* cB = (const char*)(cur.sw ? g.Bt2 : g.Bt) + (size_t)cur.pn * tstepB;
    S.a_ready(cur);
    if constexpr (SP2) {
        PG8_STAGE(PG8_SB(0, 0), cB, voffB); PG8_STAGE(PG8_SB(0, 1), cB + hstepB, voffB); PG8_STAGE(PG8_SA(0, 0), cA, voffA); PG8_STAGE(PG8_SA(0, 1), cA + hstepA, voffA);
        if (wr == 1) PG8_BAR;
        PG8_WAIT_V(2); PG8_BAR;
        PG8_STAGE(PG8_SB(1, 0), cB + kstep, voffB); PG8_STAGE(PG8_SA(1, 0), cA + kstep, voffA); PG8_STAGE(PG8_SB(1, 1), cB + hstepB + kstep, voffB);
        PG8_WAIT_V(6); PG8_BAR;
    } else {
        PG8_STAGE(PG8_SB(0, 0), cB, voffB); PG8_STAGE(PG8_SA(0, 0), cA, voffA); PG8_STAGE(PG8_SB(0, 1), cB + hstepB, voffB); PG8_STAGE(PG8_SA(0, 1), cA + hstepA, voffA);
        if (wr == 1) PG8_BAR;
        PG8_WAIT_V(4); PG8_BAR;
        PG8_STAGE(PG8_SB(1, 0), cB + kstep, voffB); PG8_STAGE(PG8_SA(1, 0), cA + kstep, voffA); PG8_STAGE(PG8_SB(1, 1), cB + hstepB + kstep, voffB);
        PG8_WAIT_V(6); PG8_BAR;
    }
    for (;;) {
        const bool has_next = S.next(ui + 1, nxt);
        const char* nA = has_next ? (const char*)(nxt.sw ? g.A2 : g.A) + (size_t)nxt.pm * tstepA : cA; const char* nB = has_next ? (const char*)(nxt.sw ? g.Bt2 : g.Bt) + (size_t)nxt.pn * tstepB : cB;
        for (int t = 0; t < nt; t += 2) {
            const bool last = (t == nt - 2);
            const char* a1 = cA + (size_t)(t + 1) * kstep;
            const char* a2 = last ? nA : cA + (size_t)(t + 2) * kstep; const char* b2 = last ? nB : cB + (size_t)(t + 2) * kstep;
            const char* a3 = a2 + kstep; const char* b3 = b2 + kstep;
            if (last && has_next) S.a_ready(nxt);
            if constexpr (SP2) {
            PG8_LDB(B0, 0, 0); PG8_LDB(B1, 0, 1); PG8_SCHED; PG8_LDA(At, 0, 0); PG8_STAGE(PG8_SA(1, 1), a1 + hstepA, voffA);
            PG8_WAIT_V(8); PG8_WAIT_L(0); PG8_BAR; PG8_MMA(0, 0, At, B0); PG8_MMA(0, 1, At, B1); PG8_BAR; PG8_SCHED;
            PG8_LDA(At, 0, 1); PG8_STAGE(PG8_SB(0, 0), b2, voffB); PG8_STAGE(PG8_SB(0, 1), b2 + hstepB, voffB); PG8_STAGE(PG8_SA(0, 0), a2, voffA);
            PG8_WAIT_V(8); PG8_WAIT_L(0); PG8_BAR; PG8_MMA(1, 0, At, B0); PG8_MMA(1, 1, At, B1); PG8_BAR; PG8_SCHED;
            PG8_LDB(B0, 1, 0); PG8_LDB(B1, 1, 1); PG8_SCHED; PG8_LDA(At, 1, 0); PG8_STAGE(PG8_SA(0, 1), a2 + hstepA, voffA);
            PG8_WAIT_V(8); PG8_WAIT_L(0); PG8_BAR; PG8_MMA(0, 0, At, B0); PG8_MMA(0, 1, At, B1); PG8_BAR; PG8_SCHED;
            PG8_LDA(At, 1, 1); PG8_STAGE(PG8_SB(1, 0), b3, voffB); PG8_STAGE(PG8_SB(1, 1), b3 + hstepB, voffB); PG8_STAGE(PG8_SA(1, 0), a3, voffA);
            PG8_WAIT_V(8); PG8_WAIT_L(0); PG8_BAR; PG8_MMA(1, 0, At, B0); PG8_MMA(1, 1, At, B1); PG8_BAR; PG8_SCHED;
            } else {
            PG8_LDB(B0, 0, 0); PG8_SCHED; PG8_LDA(At, 0, 0); PG8_STAGE(PG8_SA(1, 1), a1 + hstepA, voffA);
            PG8_WAIT_L(8); PG8_BAR; PG8_WAIT_L(0); PG8_MMA(0, 0, At, B0); PG8_BAR; PG8_SCHED;
            PG8_LDB(B1, 0, 1); PG8_STAGE(PG8_SB(0, 0), b2, voffB);
            PG8_BAR; PG8_WAIT_L(0); PG8_MMA(0, 1, At, B1); PG8_BAR;
            PG8_LDA(At, 0, 1); PG8_STAGE(PG8_SA(0, 0), a2, voffA);
            PG8_BAR; PG8_WAIT_L(0); PG8_MMA(1, 0, At, B0); PG8_BAR; PG8_SCHED;
            PG8_STAGE(PG8_SB(0, 1), b2 + hstepB, voffB);
            PG8_WAIT_V(6); PG8_BAR; PG8_MMA(1, 1, At, B1); PG8_BAR;
            PG8_LDB(B0, 1, 0); PG8_SCHED; PG8_LDA(At, 1, 0); PG8_STAGE(PG8_SA(0, 1), a2 + hstepA, voffA);
            PG8_WAIT_L(8); PG8_BAR; PG8_WAIT_L(0); PG8_MMA(0, 0, At, B0); PG8_BAR; PG8_SCHED;
            PG8_LDB(B1, 1, 1); PG8_STAGE(PG8_SB(1, 0), b3, voffB);
            PG8_BAR; PG8_WAIT_L(0); PG8_MMA(0, 1, At, B1); PG8_BAR;
            PG8_LDA(At, 1, 1); PG8_STAGE(PG8_SA(1, 0), a3, voffA);
            PG8_BAR; PG8_WAIT_L(0); PG8_MMA(1, 0, At, B0); PG8_BAR; PG8_SCHED;
            PG8_STAGE(PG8_SB(1, 1), b3 + hstepB, voffB);
            PG8_WAIT_V(6); PG8_BAR; PG8_MMA(1, 1, At, B1); PG8_BAR;
            }
        }
        if constexpr (ALIGN_EPI) { if (wr == 0) PG8_BAR; }
        if constexpr (!Epi::AFTER_DRAIN) { E(acc, cur, wr, wc, fr, fq); S.done(cur); }
        if (!has_next) break;
#pragma unroll
        for (int a = 0; a < 2; ++a)
#pragma unroll
            for (int b = 0; b < 2; ++b)
#pragma unroll
                for (int m = 0; m < 4; ++m)
#pragma unroll
                    for (int n = 0; n < 2; ++n) acc[a][b][m][n] = (f32x4){0.f, 0.f, 0.f, 0.f};
        cur = nxt; cA = nA; cB = nB; ++ui;
        if constexpr (ALIGN_EPI) { if (wr == 1) PG8_BAR; }
    }
    PG8_WAIT_V(0);
    if constexpr (!ALIGN_EPI) { if (wr == 0) PG8_BAR; }
    PG8_BAR;
    if constexpr (Epi::AFTER_DRAIN) { E.fused(acc, cur, wr, wc, fr, fq, lds, wid, lane); S.done(cur); }
#undef PG8_SA
#undef PG8_SB
#undef PG8_STAGE
#undef PG8_LDA
#undef PG8_LDB
#undef PG8_MMA
#undef PG8_WAIT_V
#undef PG8_WAIT_L
#undef PG8_BAR
#undef PG8_SCHED
}
}
#define LAS __attribute__((address_space(3)))
typedef unsigned short bf16;
typedef unsigned u32x4 __attribute__((ext_vector_type(4)));
typedef unsigned u32x2 __attribute__((ext_vector_type(2)));
typedef float f32x4 __attribute__((ext_vector_type(4)));
typedef float f32x16 __attribute__((ext_vector_type(16)));
typedef short bf16x8 __attribute__((ext_vector_type(8)));
typedef short s16x4 __attribute__((ext_vector_type(4)));
typedef LAS unsigned char* ldsp;
typedef unsigned long long u64;
#define DI __device__ __forceinline__
DI int tid_of(int wv) { int ln; asm volatile("v_mbcnt_lo_u32_b32 %0, -1, 0\n\tv_mbcnt_hi_u32_b32 %0, -1, %0" : "=v"(ln)); return wv * 64 + ln; }
DI float shx(float v, int m, int lane) { return __builtin_bit_cast(float, __builtin_amdgcn_ds_bpermute((lane ^ m) << 2, __builtin_bit_cast(int, v))); }
DI float shup(float v, int d, int lane) { const int src = lane >= d ? lane - d : lane; return __builtin_bit_cast(float, __builtin_amdgcn_ds_bpermute(src << 2, __builtin_bit_cast(int, v))); }

constexpr int BATCH = 2, T = 8192, DM = 2048, M = BATCH * T, FF = 5632, INW = 5664, HD = 128;
constexpr int N1 = 4352, N2 = 1536, NGU = 2 * FF;
constexpr float EPS = 1e-6f;
constexpr float LOG2E = 1.4426950408889634f;
constexpr float C2 = 0.08838834764831845f * 1.4426950408889634f;
constexpr int NWAVES = 8, NTHR = 512;
constexpr int LDS_BYTES = 147456;

constexpr size_t MiB = 1u << 20;
constexpr size_t WL = 99 * MiB;
constexpr size_t OW1 = 0, OW2 = 17 * MiB, OWO = 23 * MiB, OWGU = 31 * MiB, OWD = 75 * MiB, OWC = 97 * MiB;
constexpr size_t WS_HEADS = 198 * MiB, WS_VT = 326 * MiB, WS_H = 198 * MiB;
constexpr size_t WS_OMIX = 374 * MiB, WS_XB = 438 * MiB;
constexpr size_t WS_MISC = 502 * MiB;
constexpr size_t WS_SCAL = WS_MISC, WS_CUMB = WS_MISC + 2 * MiB, WS_KCRAW = WS_MISC + 3 * MiB, WS_KCMP = WS_MISC + 4 * MiB,
                 WS_VCT = WS_MISC + 4 * MiB + 512 * 1024, WS_SS = WS_MISC + 5 * MiB, WS_PB = WS_SS + 4 * 65536,
                 WS_KRAW2 = WS_MISC + 6 * MiB  , WS_VRAW2 = WS_MISC + 8 * MiB  , WS_END = WS_MISC + 10 * MiB;
constexpr size_t WS_BAR = WS_PB + 4096, WS_CCTR = WS_BAR + 14336, WS_QCTR = WS_BAR + 15360;
constexpr size_t ZERO_OFF = WS_SS + 65536, ZERO_BYTES = 3 * 65536 + 4096 + 16384;

DI unsigned f2bf(float f) { unsigned u = __builtin_bit_cast(unsigned, f); return (u + 0x7fffu + ((u >> 16) & 1u)) >> 16; }
typedef float f32x2_t __attribute__((ext_vector_type(2)));
typedef __bf16 bf16x2_t __attribute__((ext_vector_type(2)));
DI unsigned pk2(float lo, float hi) { f32x2_t v = {lo, hi}; bf16x2_t b = __builtin_convertvector(v, bf16x2_t); return __builtin_bit_cast(unsigned, b); }
DI float bf2f(unsigned short b) { return __builtin_bit_cast(float, (unsigned)b << 16); }
DI float fexp2(float x) { return __builtin_amdgcn_exp2f(x); }

struct EpiProj {
    static constexpr bool PERM = true, AFTER_DRAIN = false;
    bf16* heads; float* scal; const float* ss;
    DI void operator()(const f32x4 (&acc)[2][2][4][2], const pg8::Unit& u, int wr, int wc, int fr, int fq) const {
#pragma unroll
        for (int ai = 0; ai < 2; ++ai)
#pragma unroll
            for (int m = 0; m < 4; ++m) {
                const int row = u.pm * 256 + ai * 128 + wr * 64 + m * 16 + fr;
                const float rs = rsqrtf(ss[row] * (1.0f / DM) + EPS);
                if (u.pn < 16) {
#pragma unroll
                    for (int bj = 0; bj < 2; ++bj) {
                        const int slot = 2 * u.pn + bj;
                        bf16* dst = heads + ((size_t)slot * M + row) * HD + wc * 32 + 8 * fq;
                        const f32x4 a = acc[ai][bj][m][0] * rs, b = acc[ai][bj][m][1] * rs;
                        u32x4 w; w.x = pk2(a[0], a[1]); w.y = pk2(a[2], a[3]); w.z = pk2(b[0], b[1]); w.w = pk2(b[2], b[3]);
                        *(u32x4*)dst = w;
                    }
                } else if (wc == 0) {
                    float* dst = scal + (size_t)row * 32 + 8 * fq;
                    *(f32x4*)dst = acc[ai][0][m][0] * rs; *(f32x4*)(dst + 4) = acc[ai][0][m][1] * rs;
                }
            }
    }
};
struct EpiVT {
    static constexpr bool PERM = true, AFTER_DRAIN = false;
    bf16* vt; const float* ss;
    DI void operator()(const f32x4 (&acc)[2][2][4][2], const pg8::Unit& u, int wr, int wc, int fr, int fq) const {
        float rs[2][8];
#pragma unroll
        for (int bj = 0; bj < 2; ++bj) { const int c0 = u.pn * 256 + bj * 128 + wc * 32 + 8 * fq;
#pragma unroll
            for (int e = 0; e < 8; ++e) rs[bj][e] = rsqrtf(ss[c0 + e] * (1.0f / DM) + EPS); }
#pragma unroll
        for (int ai = 0; ai < 2; ++ai)
#pragma unroll
            for (int m = 0; m < 4; ++m) {
                const int row = u.pm * 256 + ai * 128 + wr * 64 + m * 16 + fr;
#pragma unroll
                for (int bj = 0; bj < 2; ++bj) {
                    const int c0 = u.pn * 256 + bj * 128 + wc * 32 + 8 * fq;
                    const f32x4 a = acc[ai][bj][m][0], b = acc[ai][bj][m][1];
                    u32x4 w; w.x = pk2(a[0] * rs[bj][0], a[1] * rs[bj][1]); w.y = pk2(a[2] * rs[bj][2], a[3] * rs[bj][3]);
                    w.z = pk2(b[0] * rs[bj][4], b[1] * rs[bj][5]); w.w = pk2(b[2] * rs[bj][6], b[3] * rs[bj][7]);
                    *(u32x4*)(vt + (((size_t)(row >> 7) * (M / 64) + (c0 >> 6)) * 128 + (row & 127)) * 64 + (c0 & 63)) = w;
                }
            }
    }
};
struct EpiRes {
    static constexpr bool PERM = true, AFTER_DRAIN = false;
    float* xout; bf16* xb; float* ssout; ldsp red;
    DI void operator()(const f32x4 (&acc)[2][2][4][2], const pg8::Unit& u, int wr, int wc, int fr, int fq) const {
#pragma unroll
        for (int ai = 0; ai < 2; ++ai)
#pragma unroll
            for (int m = 0; m < 4; ++m) {
                const int row = u.pm * 256 + ai * 128 + wr * 64 + m * 16 + fr;
                float sq = 0.f;
#pragma unroll
                for (int bj = 0; bj < 2; ++bj) {
                    const size_t off = (size_t)row * DM + u.pn * 256 + bj * 128 + wc * 32 + 8 * fq;
                    const u32x4 r = *(const u32x4*)(xb + off);
                    f32x4 a, b;
                    a[0] = __builtin_bit_cast(float, r.x << 16); a[1] = __builtin_bit_cast(float, r.x & 0xffff0000u); a[2] = __builtin_bit_cast(float, r.y << 16); a[3] = __builtin_bit_cast(float, r.y & 0xffff0000u);
                    b[0] = __builtin_bit_cast(float, r.z << 16); b[1] = __builtin_bit_cast(float, r.z & 0xffff0000u); b[2] = __builtin_bit_cast(float, r.w << 16); b[3] = __builtin_bit_cast(float, r.w & 0xffff0000u);
                    a += acc[ai][bj][m][0]; b += acc[ai][bj][m][1];
                    if (xout) { *(f32x4*)(xout + off) = a; *(f32x4*)(xout + off + 4) = b; }
                    else { u32x4 w; w.x = pk2(a[0], a[1]); w.y = pk2(a[2], a[3]); w.z = pk2(b[0], b[1]); w.w = pk2(b[2], b[3]); *(u32x4*)(xb + off) = w; }
                    sq += (a[0] * a[0] + a[1] * a[1]) + (a[2] * a[2] + a[3] * a[3]) + (b[0] * b[0] + b[1] * b[1]) + (b[2] * b[2] + b[3] * b[3]);
                }
                if (ssout) { const int lane_ = fq * 16 + fr; sq += shx(sq, 16, lane_); sq += shx(sq, 32, lane_);
                    if (fq == 0) *(LAS float*)(red + ((ai * 128 + wr * 64 + m * 16 + fr) * 4 + wc) * 4) = sq; }
            }
        if (ssout) {
            asm volatile("s_waitcnt lgkmcnt(0)" ::: "memory");
            __builtin_amdgcn_s_barrier();
            asm volatile("" ::: "memory");
            const int tid_ = (wr * 4 + wc) * 64 + fq * 16 + fr;
            if (tid_ < 256) { const f32x4 pr = *(const LAS f32x4*)(red + tid_ * 16); atomicAdd(ssout + u.pm * 256 + tid_, (pr[0] + pr[1]) + (pr[2] + pr[3])); }
        }
    }
};
struct EpiGU {
    static constexpr bool PERM = true, AFTER_DRAIN = false;
    bf16* h; const float* ss;
    DI void operator()(const f32x4 (&acc)[2][2][4][2], const pg8::Unit& u, int wr, int wc, int fr, int fq) const {
#pragma unroll
        for (int ai = 0; ai < 2; ++ai)
#pragma unroll
            for (int m = 0; m < 4; ++m) {
                const int row = u.pm * 256 + ai * 128 + wr * 64 + m * 16 + fr;
                const float rs = rsqrtf(ss[row] * (1.0f / DM) + EPS);
                float o[8];
#pragma unroll
                for (int n = 0; n < 2; ++n)
#pragma unroll
                    for (int e = 0; e < 4; ++e) { const float g = acc[ai][0][m][n][e] * rs, up = acc[ai][1][m][n][e] * rs;
                        o[4 * n + e] = g * up * __builtin_amdgcn_rcpf(1.0f + fexp2(-LOG2E * g)); }
                u32x4 w; w.x = pk2(o[0], o[1]); w.y = pk2(o[2], o[3]); w.z = pk2(o[4], o[5]); w.w = pk2(o[6], o[7]);
                *(u32x4*)(h + (size_t)row * FF + u.pn * 128 + wc * 32 + 8 * fq) = w;
            }
    }
};
struct EpiCmpK {
    static constexpr bool PERM = true, AFTER_DRAIN = false;
    float* kraw;
    DI void operator()(const f32x4 (&acc)[2][2][4][2], const pg8::Unit& u, int wr, int wc, int fr, int fq) const {
#pragma unroll
        for (int ai = 0; ai < 2; ++ai)
#pragma unroll
            for (int m = 0; m < 4; ++m) {
                const int row = u.pm * 256 + ai * 128 + wr * 64 + m * 16 + fr;
                float* dst = kraw + (size_t)row * HD + wc * 32 + 8 * fq;
                *(f32x4*)dst = acc[ai][0][m][0]; *(f32x4*)(dst + 4) = acc[ai][0][m][1];
            }
    }
};
struct EpiCmpVraw {
    static constexpr bool PERM = true, AFTER_DRAIN = false;
    float* vraw;
    DI void operator()(const f32x4 (&acc)[2][2][4][2], const pg8::Unit& u, int wr, int wc, int fr, int fq) const {
#pragma unroll
        for (int m = 0; m < 4; ++m) {
            const int e = wr * 64 + m * 16 + fr;
#pragma unroll
            for (int bj = 0; bj < 2; ++bj) {
                float* dst = vraw + (size_t)e * 2048 + u.pn * 256 + bj * 128 + wc * 32 + 8 * fq;
                *(f32x4*)dst = acc[1][bj][m][0]; *(f32x4*)(dst + 4) = acc[1][bj][m][1];
            }
        }
    }
};
struct EpiCmpV {
    static constexpr bool PERM = true, AFTER_DRAIN = false;
    bf16* vct; const float* pbv;
    DI void operator()(const f32x4 (&acc)[2][2][4][2], const pg8::Unit& u, int wr, int wc, int fr, int fq) const {
#pragma unroll
        for (int m = 0; m < 4; ++m) {
            const int e = wr * 64 + m * 16 + fr; const float pb = pbv[e];
#pragma unroll
            for (int bj = 0; bj < 2; ++bj) {
                const int c0 = u.pn * 256 + bj * 128 + wc * 32 + 8 * fq;
                const f32x4 a = acc[1][bj][m][0] + pb, b = acc[1][bj][m][1] + pb;
                u32x4 w; w.x = pk2(a[0], a[1]); w.y = pk2(a[2], a[3]); w.z = pk2(b[0], b[1]); w.w = pk2(b[2], b[3]);
                *(u32x4*)(vct + ((size_t)(c0 >> 6) * 128 + e) * 64 + (c0 & 63)) = w;
            }
        }
    }
};
struct MergedOrder {
    pg8::StaticOrder a, b; int n1, G, c;
    DI void init(int G_, int c_) { a.init(M, N1, 1, 0); b.init(N2, M, 1, 0); n1 = a.nwg; G = G_; c = c_; }
    DI bool next(int i, pg8::Unit& u) const {
        const int L = i * G + c;
        if (L < n1) return a.next(L, u);
        if (L - n1 < b.nwg) { const bool ok = b.next(L - n1, u); u.sw = 1; return ok; }
        return false;
    }
    DI void a_ready(const pg8::Unit&) const {}
    DI void done(const pg8::Unit&) const {}
};
struct EpiInProj {
    static constexpr bool PERM = true, AFTER_DRAIN = false;
    EpiProj a; EpiVT b;
    DI void operator()(const f32x4 (&acc)[2][2][4][2], const pg8::Unit& u, int wr, int wc, int fr, int fq) const { if (u.sw) b(acc, u, wr, wc, fr, fq); else a(acc, u, wr, wc, fr, fq); }
};
struct OneUnit {
    bool has; pg8::Unit u;
    DI bool next(int i, pg8::Unit& o) const { if (i == 0 && has) { o = u; return true; } return false; }
    DI void a_ready(const pg8::Unit&) const {}
    DI void done(const pg8::Unit&) const {}
};
DI float wave_sum(float v, int lane) {
#pragma unroll
    for (int o = 1; o < 64; o <<= 1) v += shx(v, o, lane);
    return v;
}
DI int srccol_in(int type, int n) {
    if (type == 0) {
        if (n < 2048) return n;
        if (n < 3840) return n + 1032;
        if (n < 4096) return n + 1288;
        if (n < 4104) return 3072 + (n - 4096);
        if (n < 4128) return 5640 + (n - 4104);
        return -1;
    }
    if (n < 1024) return 2048 + n;
    if (n < 1280) return 4872 + (n - 1024);
    return 5384 + (n - 1280);
}
DI void tr_item(const float* W, int ldw, int k0, int col, const float* gain, bf16* dst_n0, int K, LAS float* scr, int lane) {
    const int kr = lane >> 4, c4 = lane & 15;
    f32x4 v[16];
#pragma unroll
    for (int i = 0; i < 16; ++i) { v[i] = (f32x4){0.f, 0.f, 0.f, 0.f}; if (col >= 0) v[i] = *(const f32x4*)(W + (size_t)(k0 + 4 * i + kr) * ldw + col); }
    if (gain) {
#pragma unroll
        for (int i = 0; i < 16; ++i) v[i] *= gain[k0 + 4 * i + kr];
    }
#pragma unroll
    for (int i = 0; i < 16; ++i) { LAS float* d = scr + (4 * i + kr) * 65 + 4 * c4; d[0] = v[i][0]; d[1] = v[i][1]; d[2] = v[i][2]; d[3] = v[i][3]; }
    asm volatile("s_waitcnt lgkmcnt(0)" ::: "memory");
    const int c = lane & 7;
#pragma unroll
    for (int j = 0; j < 8; ++j) { const int n = (lane >> 3) + 8 * j; const LAS float* sp = scr + (8 * c) * 65 + n;
        u32x4 o; o.x = pk2(sp[0 * 65], sp[1 * 65]); o.y = pk2(sp[2 * 65], sp[3 * 65]); o.z = pk2(sp[4 * 65], sp[5 * 65]); o.w = pk2(sp[6 * 65], sp[7 * 65]);
        *(u32x4*)(dst_n0 + (size_t)n * K + k0 + 8 * c) = o; }
    asm volatile("s_waitcnt lgkmcnt(0)" ::: "memory");
}

struct P {
    const float *x, *attn_norm, *w_in, *fbias, *fqn, *fkn, *nqn, *ckn, *skn, *wkn, *cpk, *cpv, *cwk, *cwv, *w_out, *ffn_norm, *w_gate, *w_up, *w_down;
    float* out; unsigned char* ws;
};

DI void convert_weights(const P& p, ldsp lds, int l, int part, int nb, int bi, int wv) {
    const int tid = tid_of(wv), lane = tid & 63, wave = tid >> 6;
    LAS float* scr = (LAS float*)(lds + wave * 16640);
    const int gw = bi * NWAVES + wave, NGW = nb * NWAVES;
    constexpr int I1 = 32 * (N1 / 64), I2 = 32 * (N2 / 64), IO = 32 * (DM / 64), IGU = 32 * (NGU / 64), ID = (FF / 64) * (DM / 64), IC = 64 * 4;
    constexpr int IL = I1 + I2 + IO + IGU + ID + IC;
    const int nl = 4 * (lane & 15);
    const int nitems = part == 0 ? I1 + I2 + IC : IO + IGU + ID;
    for (int it = gw; it < nitems; it += NGW) {
        int r = part == 0 ? (it < I1 + I2 ? it : it + (IO + IGU + ID)) : it + I1 + I2;
        unsigned char* wl = p.ws + (size_t)l * WL;
        if (r < I1) { const int nb = r % (N1 / 64), kb = r / (N1 / 64);
            tr_item(p.w_in + (size_t)l * DM * INW, INW, kb * 64, srccol_in(0, nb * 64 + nl), p.attn_norm + l * DM, (bf16*)(wl + OW1) + (size_t)nb * 64 * DM, DM, scr, lane); continue; } r -= I1;
        if (r < I2) { const int nb = r % (N2 / 64), kb = r / (N2 / 64);
            tr_item(p.w_in + (size_t)l * DM * INW, INW, kb * 64, srccol_in(1, nb * 64 + nl), p.attn_norm + l * DM, (bf16*)(wl + OW2) + (size_t)nb * 64 * DM, DM, scr, lane); continue; } r -= I2;
        if (r < IO) { const int nb = r % (DM / 64), kb = r / (DM / 64);
            tr_item(p.w_out + (size_t)l * DM * DM, DM, kb * 64, nb * 64 + nl, nullptr, (bf16*)(wl + OWO) + (size_t)nb * 64 * DM, DM, scr, lane); continue; } r -= IO;
        if (r < IGU) { const int nb = r % (NGU / 64), kb = r / (NGU / 64); const int n = nb * 64, pp = n >> 8, sg = (n >> 7) & 1, j = n & 127;
            tr_item((sg ? p.w_up : p.w_gate) + (size_t)l * DM * FF, FF, kb * 64, 128 * pp + j + nl, p.ffn_norm + l * DM, (bf16*)(wl + OWGU) + (size_t)n * DM, DM, scr, lane); continue; } r -= IGU;
        if (r < ID) { const int nb = r % (DM / 64), kb = r / (DM / 64);
            tr_item(p.w_down + (size_t)l * FF * DM, DM, kb * 64, nb * 64 + nl, nullptr, (bf16*)(wl + OWD) + (size_t)nb * 64 * FF, FF, scr, lane); continue; } r -= ID;
        { const int nb = r % 4, kb = r / 4; const int n = nb * 64;
            tr_item((n < 128 ? p.cwk : p.cwv) + (size_t)l * 4096 * 128, 128, kb * 64, (n & 127) + nl, nullptr, (bf16*)(wl + OWC) + (size_t)n * 4096, 4096, scr, lane); }
    }
}

DI void prologue(const P& p, ldsp lds, int G, int wv) {
    convert_weights(p, lds, 0, 0, G, blockIdx.x, wv);
    const int tid = tid_of(wv), lane = tid & 63, wave = tid >> 6;
    const int gw = blockIdx.x * NWAVES + wave, NGW = G * NWAVES;
    bf16* XB = (bf16*)(p.ws + WS_XB); float* SS0 = (float*)(p.ws + WS_SS);
    for (int m = gw; m < M; m += NGW) {
        const f32x4* xr = (const f32x4*)(p.x + (size_t)m * DM) + lane; u32x2* o8 = (u32x2*)(XB + (size_t)m * DM) + lane;
        float s = 0.f;
#pragma unroll
        for (int j = 0; j < 8; ++j) { const f32x4 v = xr[64 * j]; s += (v.x * v.x + v.y * v.y) + (v.z * v.z + v.w * v.w);
            u32x2 w; w.x = pk2(v.x, v.y); w.y = pk2(v.z, v.w); o8[64 * j] = w; }
        s = wave_sum(s, lane); if (lane == 0) SS0[m] = s;
    }
    float* PB = (float*)(p.ws + WS_PB);
    for (int it = gw; it < 2 * 2 * 2 * 16; it += NGW) {
        const int kc = it & 15, eh = (it >> 4) & 1, kv = (it >> 5) & 1, l = it >> 6;
        const float* pos = (kv ? p.cpv : p.cpk) + (size_t)l * 4096; const float* w = (kv ? p.cwv : p.cwk) + (size_t)l * 4096 * 128;
        const int e = eh * 64 + lane; float a = 0.f;
        for (int k = kc * 256; k < kc * 256 + 256; ++k) a += pos[k] * w[(size_t)k * 128 + e];
        atomicAdd(PB + (l * 2 + kv) * 128 + e, a);
    }
}

DI void post_norm(const P& p, int l, int nb, int bi, int wv) {
    const int tid = tid_of(wv), lane = tid & 63, wave = tid >> 6, sub = lane & 15;
    bf16* heads = (bf16*)(p.ws + WS_HEADS);
    const int gw = bi * NWAVES + wave, NGW = nb * NWAVES;
    constexpr int NIT = 12 * (M / 8);
    for (int it = gw; it < NIT; it += NGW) {
        const int si = it / (M / 8), r8 = it % (M / 8);
        const int slot = si < 8 ? 8 + si : 20 + si;
        const float* gp = (slot < 16 ? p.fkn : (slot < 30 ? p.skn : p.wkn)) + l * HD + sub * 8;
        bf16* rowp0 = heads + ((size_t)slot * M + r8 * 8 + (lane >> 4)) * HD + sub * 8; bf16* rowp1 = rowp0 + 4 * HD;
        const u32x4 raw0 = *(const u32x4*)rowp0, raw1 = *(const u32x4*)rowp1;
        const f32x4 g0 = *(const f32x4*)gp, g1 = *(const f32x4*)(gp + 4);
        float v[8], u[8]; float s0 = 0.f, s1 = 0.f;
#pragma unroll
        for (int j = 0; j < 4; ++j) { v[2 * j] = __builtin_bit_cast(float, raw0[j] << 16); v[2 * j + 1] = __builtin_bit_cast(float, raw0[j] & 0xffff0000u);
            u[2 * j] = __builtin_bit_cast(float, raw1[j] << 16); u[2 * j + 1] = __builtin_bit_cast(float, raw1[j] & 0xffff0000u); }
#pragma unroll
        for (int j = 0; j < 8; ++j) { s0 += v[j] * v[j]; s1 += u[j] * u[j]; }
        s0 += shx(s0, 1, lane); s1 += shx(s1, 1, lane); s0 += shx(s0, 2, lane); s1 += shx(s1, 2, lane);
        s0 += shx(s0, 4, lane); s1 += shx(s1, 4, lane); s0 += shx(s0, 8, lane); s1 += shx(s1, 8, lane);
        const float r0 = rsqrtf(s0 * (1.0f / HD) + EPS), r1 = rsqrtf(s1 * (1.0f / HD) + EPS);
        u32x4 w0, w1;
        w0.x = pk2(v[0] * r0 * g0[0], v[1] * r0 * g0[1]); w0.y = pk2(v[2] * r0 * g0[2], v[3] * r0 * g0[3]); w0.z = pk2(v[4] * r0 * g1[0], v[5] * r0 * g1[1]); w0.w = pk2(v[6] * r0 * g1[2], v[7] * r0 * g1[3]);
        w1.x = pk2(u[0] * r1 * g0[0], u[1] * r1 * g0[1]); w1.y = pk2(u[2] * r1 * g0[2], u[3] * r1 * g0[3]); w1.z = pk2(u[4] * r1 * g1[0], u[5] * r1 * g1[1]); w1.w = pk2(u[6] * r1 * g1[2], u[7] * r1 * g1[3]);
        *(u32x4*)rowp0 = w0; *(u32x4*)rowp1 = w1;
    }
}
DI float log_sigmoid(float z) { const float a = fabsf(z); return fminf(z, 0.f) - 0.6931471805599453f * __builtin_amdgcn_logf(1.0f + fexp2(-LOG2E * a)); }
DI void post_cumsum(const P& p, int l, ldsp lds, int c, int wv) {
    const int tid = tid_of(wv), lane = tid & 63, wave = tid >> 6, b = c >> 3, h = c & 7;
    const float* scal = (const float*)(p.ws + WS_SCAL); float* cumb = (float*)(p.ws + WS_CUMB) + (size_t)c * T;
    const float fb = p.fbias[l * 8 + h];
    float v[16]; float run = 0.f;
#pragma unroll
    for (int j = 0; j < 16; ++j) { const int t = tid * 16 + j; run += log_sigmoid(scal[(size_t)(b * T + t) * 32 + h] + fb); v[j] = run; }
    float inc = run;
#pragma unroll
    for (int o = 1; o < 64; o <<= 1) { const float n = shup(inc, o, lane); if (lane >= o) inc += n; }
    LAS float* wt = (LAS float*)lds;
    if (lane == 63) wt[wave] = inc;
    __syncthreads();
    float base = inc - run;
    for (int w2 = 0; w2 < wave; ++w2) base += wt[w2];
#pragma unroll
    for (int j = 0; j < 16; ++j) cumb[tid * 16 + j] = -LOG2E * (base + v[j]);
    __syncthreads();
}
constexpr int KPITCH = 272, VPITCH = 144, TILEB = 17408, TILEV = 128 * VPITCH;
constexpr int A_K = 0, A_V = 2 * TILEB, A_BIAS = A_V + 2 * TILEV, A_IMPG = A_BIAS + 512, A_IMP3 = A_IMPG + 32768, A_SEL = A_IMP3 + 32768, A_WUN = A_SEL + 1024, A_LIST = A_WUN + 128;
static_assert(A_LIST + 1024 <= LDS_BYTES, "attention LDS map");
#define MFMA32(a, b, c) __builtin_amdgcn_mfma_f32_32x32x16_bf16((a), (b), (c), 0, 0, 0)
enum { MD_FOX = 0, MD_CMP1 = 1, MD_CMP2 = 2, MD_SEL = 3, MD_WIN = 4 };

struct TileRegs { u32x4 k0, k1, v0, v1; f32x4 b; };
template <int MODE> DI void tile_gload(TileRegs& r, const bf16* kt, const bf16* vt, size_t vpitch, const float* bias, int tid) {
    r.k0 = *(const u32x4*)(kt + tid * 8); r.k1 = *(const u32x4*)(kt + (tid + 512) * 8);
    if (MODE != MD_CMP1) {
        r.v0 = *(const u32x4*)(vt + tid * 8);
        r.v1 = *(const u32x4*)(vt + (tid + 512) * 8);
    }
    if (MODE == MD_FOX) { if (tid < 16) r.b = *(const f32x4*)(bias + tid * 4); }
}
template <int MODE> DI void tile_swrite(const TileRegs& r, ldsp lds, int koff, int voff, int boff, int tid) {
    ldsp kb = lds + koff, vb = lds + voff;
    *(LAS u32x4*)(kb + (tid >> 4) * KPITCH + (tid & 15) * 16) = r.k0;
    *(LAS u32x4*)(kb + ((tid >> 4) + 32) * KPITCH + (tid & 15) * 16) = r.k1;
    if (MODE != MD_CMP1) {
        const int cw = ((tid & 7) >> 1) * 32 + (tid & 1) * 8;
        ldsp a0 = vb + (tid >> 3) * VPITCH + cw, a1 = vb + ((tid >> 3) + 64) * VPITCH + cw;
        u32x2 t; t.x = r.v0.x; t.y = r.v0.y; *(LAS u32x2*)a0 = t; t.x = r.v0.z; t.y = r.v0.w; *(LAS u32x2*)(a0 + 16) = t;
        t.x = r.v1.x; t.y = r.v1.y; *(LAS u32x2*)a1 = t; t.x = r.v1.z; t.y = r.v1.w; *(LAS u32x2*)(a1 + 16) = t;
    }
    if (MODE == MD_FOX) { if (tid < 16) *(LAS f32x4*)(lds + A_BIAS + boff + tid * 16) = r.b; }
}

struct AttnCtx {
    const bf16* kmat; const bf16* vtm; size_t vpitch; const float* cumb;
    int ntiles, tile0;
    int t; float slope2;
    int whi;
    int mtile;
    u64 wun_lo, wun_hi;
    float m, l;
    float bqk;
    bool xsel;
    int qi;
};

template <int MODE> DI void attn_h1(AttnCtx& c, const bf16x8 (&q)[8], f32x16 (&o)[4], f32x16& s0, f32x16& s1, ldsp lds, int kbuf, int bbuf, int tj, int lane) {
    const int r32 = lane & 31, h = lane >> 5;
            ldsp kl = lds + kbuf + r32 * KPITCH + h * 16;
#pragma unroll
            for (int e = 0; e < 16; ++e) { s0[e] = 0.f; s1[e] = 0.f; }
#pragma unroll
            for (int s = 0; s < 8; ++s) {
                const bf16x8 ka = *(const LAS bf16x8*)(kl + s * 32), kb = *(const LAS bf16x8*)(kl + 32 * KPITCH + s * 32);
                s0 = MFMA32(ka, q[s], s0); s1 = MFMA32(kb, q[s], s1);
                if (s == 3) asm volatile("" ::: "memory");
            }
            const float NINF = -__builtin_inff();
            if (MODE == MD_FOX) {
                const LAS float* bl = (const LAS float*)(lds + A_BIAS + bbuf);
                const int kbase = tj * 64 + 4 * h;
                const bool needmask = tj >= c.whi;
#pragma unroll
                for (int g4 = 0; g4 < 4; ++g4) {
                    const f32x4 b0 = *(const LAS f32x4*)(bl + 8 * g4 + 4 * h), b1 = *(const LAS f32x4*)(bl + 32 + 8 * g4 + 4 * h);
#pragma unroll
                    for (int e = 0; e < 4; ++e) { s0[4 * g4 + e] += b0[e]; s1[4 * g4 + e] += b1[e]; }
                }
                if (needmask) {
#pragma unroll
                    for (int e = 0; e < 16; ++e) {
                        const int k0 = kbase + 8 * (e >> 2) + (e & 3);
                        s0[e] = (k0 <= c.t) ? s0[e] : NINF; s1[e] = (k0 + 32 <= c.t) ? s1[e] : NINF;
                    }
                }
            } else {
                constexpr bool CMP = (MODE == MD_CMP1 || MODE == MD_CMP2);
                constexpr int PS = CMP ? 16 : 1;
                const int P0 = CMP ? tj * 1024 + 31 : tj * 64;
                const float dbase = (float)(c.t - P0 - PS * 4 * h);
                bool selbit = true;
                if (MODE == MD_SEL) selbit = ((*(const LAS unsigned*)(lds + A_SEL + c.qi * 16 + (tj >> 5) * 4) >> (tj & 31)) & 1u) != 0u;
                bool needmask = true;
                if (MODE == MD_WIN) needmask = (tj == c.mtile) || (tj + 8 == c.mtile);
                if (MODE == MD_SEL) needmask = (tj >= c.mtile);
                if (needmask) {
#pragma unroll
                    for (int e = 0; e < 16; ++e) {
                        const float d0 = dbase - (float)(PS * (8 * (e >> 2) + (e & 3))), d1 = d0 - (float)(PS * 32);
                        bool v0 = d0 >= 0.f, v1 = d1 >= 0.f;
                        if (MODE == MD_WIN) { v0 = v0 && d0 < 512.f; v1 = v1 && d1 < 512.f; }
                        if (MODE == MD_SEL) { v0 = v0 && selbit; v1 = v1 && selbit; }
                        s0[e] = v0 ? s0[e] - c.slope2 * d0 : NINF;
                        s1[e] = v1 ? s1[e] - c.slope2 * d1 : NINF;
                    }
                } else {
                    const float a0 = selbit ? -c.slope2 * dbase : NINF;
#pragma unroll
                    for (int e = 0; e < 16; ++e) {
                        s0[e] = fmaf(c.slope2, (float)(PS * (8 * (e >> 2) + (e & 3))), s0[e] + a0);
                        s1[e] = fmaf(c.slope2, (float)(PS * (32 + 8 * (e >> 2) + (e & 3))), s1[e] + a0);
                    }
                }
            }
            if (MODE != MD_CMP2) {
                float mx = s0[0];
#pragma unroll
                for (int e = 1; e < 16; ++e) mx = fmaxf(mx, s0[e]);
#pragma unroll
                for (int e = 0; e < 16; ++e) mx = fmaxf(mx, s1[e]);
                { typedef unsigned u2_t __attribute__((ext_vector_type(2)));
                  const unsigned mb = __builtin_bit_cast(unsigned, mx);
                  const u2_t sw = __builtin_amdgcn_permlane32_swap(mb, mb, false, false);
                  mx = fmaxf(__builtin_bit_cast(float, sw.x), __builtin_bit_cast(float, sw.y)); }
                const bool need = mx > c.m + 8.0f;
                if (__ballot(need) != 0ull) {
                    const float mnew = need ? mx : c.m;
                    const float alpha = fexp2(c.m - ((mnew == NINF) ? 0.f : mnew));
                    c.l *= alpha; c.m = mnew;
                    if (MODE != MD_CMP1) {
#pragma unroll
                        for (int db = 0; db < 4; ++db)
#pragma unroll
                            for (int e = 0; e < 16; ++e) o[db][e] *= alpha;
                    }
                }
            }
}
template <int MODE> DI void attn_h2(AttnCtx& c, f32x16 (&o)[4], f32x16& s0, f32x16& s1, ldsp lds, int vbuf, int tj, int lane) {
    const int r32 = lane & 31, h = lane >> 5;
    const float NINF = -__builtin_inff();
            if (MODE == MD_CMP2) {
#pragma unroll
                for (int e = 0; e < 16; ++e) { s0[e] = fexp2(s0[e] - c.m) * c.l; s1[e] = fexp2(s1[e] - c.m) * c.l; }
                LAS float* impg = (LAS float*)(lds + A_IMPG) + c.qi * 128; LAS float* imp3 = (LAS float*)(lds + A_IMP3) + c.qi * 128;
#pragma unroll
                for (int kb = 0; kb < 2; ++kb)
#pragma unroll
                    for (int g4 = 0; g4 < 4; ++g4) {
                        float G, p3;
                        if (kb == 0) { G = (s0[4 * g4] + s0[4 * g4 + 1]) + (s0[4 * g4 + 2] + s0[4 * g4 + 3]); p3 = s0[4 * g4 + 3]; }
                        else { G = (s1[4 * g4] + s1[4 * g4 + 1]) + (s1[4 * g4 + 2] + s1[4 * g4 + 3]); p3 = s1[4 * g4 + 3]; }
                        G += shx(G, 1, lane); G += shx(G, 2, lane); p3 += shx(p3, 1, lane); p3 += shx(p3, 2, lane);
                        const int n4 = tj * 16 + kb * 8 + 2 * g4 + h;
                        if ((lane & 3) == 0) { impg[n4] = G; if (n4 + 1 < 128) imp3[n4 + 1] = p3; }
                    }
            } else {
                const float muse = (c.m == NINF) ? 0.f : c.m;
                float ps = 0.f;
#pragma unroll
                for (int e = 0; e < 16; ++e) { s0[e] = fexp2(s0[e] - muse); s1[e] = fexp2(s1[e] - muse); ps += s0[e] + s1[e]; }
                c.l += ps;
                        }
            if (MODE != MD_CMP1) {
                ldsp vl = lds + vbuf + r32 * VPITCH + 16 * h;
#pragma unroll
                for (int kb = 0; kb < 2; ++kb)
#pragma unroll
                    for (int s2 = 0; s2 < 2; ++s2) {
                        u32x4 pw;
                        if (kb == 0) { pw.x = pk2(s0[8 * s2], s0[8 * s2 + 1]); pw.y = pk2(s0[8 * s2 + 2], s0[8 * s2 + 3]); pw.z = pk2(s0[8 * s2 + 4], s0[8 * s2 + 5]); pw.w = pk2(s0[8 * s2 + 6], s0[8 * s2 + 7]); }
                        else { pw.x = pk2(s1[8 * s2], s1[8 * s2 + 1]); pw.y = pk2(s1[8 * s2 + 2], s1[8 * s2 + 3]); pw.z = pk2(s1[8 * s2 + 4], s1[8 * s2 + 5]); pw.w = pk2(s1[8 * s2 + 6], s1[8 * s2 + 7]); }
                        const bf16x8 pf = __builtin_bit_cast(bf16x8, pw);
#pragma unroll
                        for (int db = 0; db < 4; ++db) {
                            const bf16x8 vf = *(const LAS bf16x8*)(vl + db * 32 * VPITCH + (kb * 2 + s2) * 32);
                            o[db] = MFMA32(vf, pf, o[db]);
                        }
                    }
            }
        }
template <int MODE> DI void attn_run(AttnCtx& c, const bf16x8 (&q)[8], f32x16 (&o)[4], ldsp lds, int tid, int wv) {
    constexpr bool STAG = (MODE == MD_FOX);
    const int lane = tid & 63;
    const bool grpB = STAG && (wv >= 4);
    const LAS int* list = (const LAS int*)(lds + A_LIST);
    if (c.ntiles <= 0) return;
    TileRegs tr;
#define TILE_ID(i) ((MODE == MD_SEL) ? list[(i)] : c.tile0 + c.ntiles - 1 - (i))
#define VBUF(m3) (STAG ? ((m3) == 2 ? A_IMPG : A_V + (m3) * TILEV) : A_V + (m3) * TILEV)
    { const int tj = TILE_ID(0);
      tile_gload<MODE>(tr, c.kmat + (size_t)tj * 64 * HD, c.vtm + (size_t)tj * 8192, c.vpitch, c.cumb + (size_t)tj * 64, tid);
      tile_swrite<MODE>(tr, lds, A_K, VBUF(0), 0, tid); }
    __syncthreads();
    f32x16 s0, s1;
    bool dprev = false; int tjprev = 0, m3 = 0, m3prev = 0;
    volatile LAS unsigned* xflag = (volatile LAS unsigned*)(lds + A_LIST + 768);
    bool wneed = true;
    for (int i = 0; i < c.ntiles; ++i) {
        const int cur = i & 1, tj = TILE_ID(i);
        const int m3n = STAG ? (m3 == 2 ? 0 : m3 + 1) : (m3 ^ 1);
        float cb_next = 0.f;
        if (MODE == MD_FOX || ((MODE == MD_SEL || MODE == MD_CMP1 || MODE == MD_CMP2) && c.xsel)) {
            if (i > 0) {
                unsigned any = 0u;
#pragma unroll
                for (int k = 0; k < NWAVES; ++k) any |= xflag[((i - 1) & 1) * NWAVES + k];
                if (any == 0u) break;
            }
            if (MODE == MD_FOX) { if (i + 1 < c.ntiles) cb_next = c.cumb[(size_t)TILE_ID(i + 1) * 64 + 63]; }
            else if (MODE == MD_SEL) { if (i + 1 < c.ntiles) cb_next = -c.slope2 * (float)(c.t - (TILE_ID(i + 1) * 64 + 63)); }
            else { if (i + 1 < c.ntiles) cb_next = -c.slope2 * (float)(c.t - (TILE_ID(i + 1) * 1024 + 1039)); }
        }
        if (i + 1 < c.ntiles) { const int tn = TILE_ID(i + 1);
            tile_gload<MODE>(tr, c.kmat + (size_t)tn * 64 * HD, c.vtm + (size_t)tn * 8192, c.vpitch, c.cumb + (size_t)tn * 64, tid); }
        if (STAG) { if (grpB && dprev) attn_h2<MODE>(c, o, s0, s1, lds, VBUF(m3prev), tjprev, lane); }
        bool doit = (tj <= c.whi) && wneed;
        if (MODE == MD_SEL) doit = wneed && (((tj < 64 ? (c.wun_lo >> tj) : (c.wun_hi >> (tj - 64))) & 1ull) != 0ull);
        if (doit) attn_h1<MODE>(c, q, o, s0, s1, lds, A_K + cur * TILEB, cur * 256, tj, lane);
        if (!grpB && doit) attn_h2<MODE>(c, o, s0, s1, lds, VBUF(m3), tj, lane);
        dprev = doit; tjprev = tj; m3prev = m3;
        if (i + 1 < c.ntiles) tile_swrite<MODE>(tr, lds, A_K + (cur ^ 1) * TILEB, VBUF(m3n), (cur ^ 1) * 256, tid);
        m3 = m3n;
        if (MODE == MD_FOX || ((MODE == MD_SEL || MODE == MD_CMP1 || MODE == MD_CMP2) && c.xsel)) {
            const bool needs = (cb_next + c.bqk >= c.m - 32.0f);
            const unsigned wn = (__ballot(needs) != 0ull) ? 1u : 0u;
            wneed = (wn != 0u);
            if (lane == 0) xflag[(i & 1) * NWAVES + wv] = wn;
        }
        __syncthreads();
    }
    if (STAG) { if (grpB && dprev) attn_h2<MODE>(c, o, s0, s1, lds, VBUF(m3prev), tjprev, lane); __syncthreads(); }
#undef VBUF
#undef TILE_ID
}
DI void load_q(bf16x8 (&q)[8], const bf16* qrow, int h, const float* gain, int lane) {
    float ss = 0.f;
#pragma unroll
    for (int s = 0; s < 8; ++s) { const u32x4 raw = *(const u32x4*)(qrow + 16 * s + 8 * h);
#pragma unroll
        for (int j = 0; j < 4; ++j) { const float a = __builtin_bit_cast(float, raw[j] << 16), b = __builtin_bit_cast(float, raw[j] & 0xffff0000u); ss += a * a + b * b; } }
    ss += shx(ss, 32, lane);
    const float rs = rsqrtf(ss * (1.0f / HD) + EPS) * C2;
    asm volatile("" ::: "memory");
#pragma unroll
    for (int s = 0; s < 8; ++s) {
        const u32x4 raw = *(const u32x4*)(qrow + 16 * s + 8 * h);
        const f32x4 g0 = *(const f32x4*)(gain + 16 * s + 8 * h), g1 = *(const f32x4*)(gain + 16 * s + 8 * h + 4);
        u32x4 w;
        w.x = pk2(__builtin_bit_cast(float, raw.x << 16) * rs * g0[0], __builtin_bit_cast(float, raw.x & 0xffff0000u) * rs * g0[1]);
        w.y = pk2(__builtin_bit_cast(float, raw.y << 16) * rs * g0[2], __builtin_bit_cast(float, raw.y & 0xffff0000u) * rs * g0[3]);
        w.z = pk2(__builtin_bit_cast(float, raw.z << 16) * rs * g1[0], __builtin_bit_cast(float, raw.z & 0xffff0000u) * rs * g1[1]);
        w.w = pk2(__builtin_bit_cast(float, raw.w << 16) * rs * g1[2], __builtin_bit_cast(float, raw.w & 0xffff0000u) * rs * g1[3]);
        q[s] = __builtin_bit_cast(bf16x8, w);
    }
}
DI void zero_o(f32x16 (&o)[4]) {
#pragma unroll
    for (int db = 0; db < 4; ++db)
#pragma unroll
        for (int e = 0; e < 16; ++e) o[db][e] = 0.f;
}
DI void fox_unit(const P& p, ldsp lds, int u, int l, int wv) {
    const int tid = tid_of(wv), lane = tid & 63, w = tid >> 6, r32 = lane & 31, h = lane >> 5;
    const int qb = 31 - (u >> 4), bh = u & 15, b = bh >> 3, hd = bh & 7;
    const bf16* heads = (const bf16*)(p.ws + WS_HEADS); const bf16* VT = (const bf16*)(p.ws + WS_VT);
    const int t = qb * 256 + w * 32 + r32;
    bf16x8 q[8]; load_q(q, heads + ((size_t)hd * M + b * T + t) * HD, h, p.fqn + l * HD, lane);
    f32x16 o[4]; zero_o(o);
    AttnCtx c;
    c.kmat = heads + ((size_t)(8 + hd) * M + b * T) * HD; c.vtm = VT + ((size_t)hd * (M / 64) + b * (T / 64)) * 8192; c.vpitch = 64;
    c.cumb = (const float*)(p.ws + WS_CUMB) + (size_t)bh * T;
    int tstart;
    { const float* fq = p.fqn + l * HD; const float* fk = p.fkn + l * HD;
      float gq = fmaxf(fabsf(fq[lane]), fabsf(fq[lane + 64])), gk = fmaxf(fabsf(fk[lane]), fabsf(fk[lane + 64]));
#pragma unroll
      for (int o2 = 1; o2 < 64; o2 <<= 1) { gq = fmaxf(gq, shx(gq, o2, lane)); gk = fmaxf(gk, shx(gk, o2, lane)); }
      const float BQK = 1.02f * C2 * 128.0f * gq * gk;
      c.bqk = BQK; c.xsel = false;
      const float thr = c.cumb[qb * 256] - 2.0f * BQK - 32.0f;
      const int nt = 4 * qb + 4;
      const bool skip0 = (lane < nt) && (c.cumb[lane * 64 + 63] < thr);
      const bool skip1 = (lane + 64 < nt) && (c.cumb[(lane + 64) * 64 + 63] < thr);
      tstart = __popcll(__ballot(skip0)) + __popcll(__ballot(skip1)); }
    c.ntiles = 4 * qb + 4 - tstart; c.tile0 = tstart; c.mtile = 0; c.t = t; c.slope2 = 0.f; c.whi = 4 * qb + (w >> 1); c.wun_lo = 0; c.wun_hi = 0;
    c.m = -__builtin_inff(); c.l = 0.f; c.qi = 0;
    attn_run<MD_FOX>(c, q, o, lds, tid, wv);
    const float lt = c.l + shx(c.l, 32, lane); const float inv = lt > 0.f ? 1.0f / lt : 0.f;
    bf16* orow = (bf16*)(p.ws + WS_OMIX) + (size_t)(b * T + t) * DM + hd * HD + 4 * h;
#pragma unroll
    for (int db = 0; db < 4; ++db)
#pragma unroll
        for (int g4 = 0; g4 < 4; ++g4) {
            u32x2 wv; wv.x = pk2(o[db][4 * g4] * inv, o[db][4 * g4 + 1] * inv); wv.y = pk2(o[db][4 * g4 + 2] * inv, o[db][4 * g4 + 3] * inv);
            *(u32x2*)(orow + 32 * db + 8 * g4) = wv;
        }
}
DI float sigmoidf_(float x) { return 1.0f / (1.0f + __expf(-x)); }
template <int STEP> DI void nsa_store(const f32x16 (&o)[4], float sc, ldsp acc, bf16* orow) {
#pragma unroll
    for (int db = 0; db < 4; ++db)
#pragma unroll
        for (int g4 = 0; g4 < 4; ++g4) {
            f32x4 v; v[0] = o[db][4 * g4] * sc; v[1] = o[db][4 * g4 + 1] * sc; v[2] = o[db][4 * g4 + 2] * sc; v[3] = o[db][4 * g4 + 3] * sc;
            ldsp a = acc + (db * 4 + g4) * 512;
            if (STEP >= 1) { const u32x2 r = *(const LAS u32x2*)a;
                v[0] += __builtin_bit_cast(float, r.x << 16); v[1] += __builtin_bit_cast(float, r.x & 0xffff0000u); v[2] += __builtin_bit_cast(float, r.y << 16); v[3] += __builtin_bit_cast(float, r.y & 0xffff0000u); }
            u32x2 wv; wv.x = pk2(v[0], v[1]); wv.y = pk2(v[2], v[3]);
            if (STEP <= 1) *(LAS u32x2*)a = wv; else *(u32x2*)(orow + 32 * db + 8 * g4) = wv;
        }
}
DI void nsa_unit(const P& p, ldsp lds, int u, int l, int wv) {
    const int tid = tid_of(wv), lane = tid & 63, w = tid >> 6, r32 = lane & 31, h = lane >> 5;
    const int qb = 127 - (u >> 2), bg = u & 3, b = bg >> 1, g = bg & 1;
    const bf16* heads = (const bf16*)(p.ws + WS_HEADS); const bf16* VT = (const bf16*)(p.ws + WS_VT);
    const int ql = r32 >> 2, r = r32 & 3, qi = w * 8 + ql, t = qb * 64 + qi, hn = g * 4 + r;
#pragma unroll
    for (int k = 0; k < 8; ++k) *(LAS f32x4*)(lds + A_IMPG + (k * 512 + tid) * 16) = (f32x4){0.f, 0.f, 0.f, 0.f};
    bf16x8 q[8]; load_q(q, heads + ((size_t)(16 + hn) * M + b * T + t) * HD, h, p.nqn + l * HD, lane);
#define NSA_GATE(k) sigmoidf_(((const float*)(p.ws + WS_SCAL))[(size_t)(b * T + t) * 32 + 8 + hn * 3 + (k)])
#define NSA_OACC (lds + A_IMPG + w * 8192 + lane * 8)
#define NSA_OROW ((bf16*)(p.ws + WS_OMIX) + (size_t)(b * T + t) * DM + 1024 + hn * HD + 4 * h)
    f32x16 o[4]; zero_o(o);
    AttnCtx c;
    c.bqk = 0.f; c.xsel = (g == 0);
    if (g == 0) { const float* fq = p.nqn + l * HD; const float* fk = p.skn + l * HD; const float* fc = p.ckn + l * HD;
      float gq = fmaxf(fabsf(fq[lane]), fabsf(fq[lane + 64])), gk = fmaxf(fmaxf(fabsf(fk[lane]), fabsf(fk[lane + 64])), fmaxf(fabsf(fc[lane]), fabsf(fc[lane + 64])));
#pragma unroll
      for (int o2 = 1; o2 < 64; o2 <<= 1) { gq = fmaxf(gq, shx(gq, o2, lane)); gk = fmaxf(gk, shx(gk, o2, lane)); }
      c.bqk = 1.02f * C2 * 128.0f * gq * gk; }
    c.t = t; c.mtile = qb; c.slope2 = LOG2E * exp2f(-(float)(hn + 1)); c.wun_lo = 0; c.wun_hi = 0; c.qi = qi; c.cumb = (const float*)(p.ws + WS_CUMB);
    const float NINF = -__builtin_inff();
    c.kmat = (const bf16*)(p.ws + WS_KCMP) + (size_t)(g * 1024 + b * 512) * HD; c.vtm = (const bf16*)(p.ws + WS_VCT) + (size_t)((g * 1024 + b * 512) / 64) * 8192; c.vpitch = 64;
    c.ntiles = (4 * qb + 2) / 64 + 1; c.tile0 = 0; c.whi = 1 << 30; c.m = NINF; c.l = 0.f;
    attn_run<MD_CMP1>(c, q, o, lds, tid, wv);
    { const float lt = c.l + shx(c.l, 32, lane); c.l = lt > 0.f ? 1.0f / lt : 0.f; c.m = (c.m == NINF) ? 0.f : c.m; }
    attn_run<MD_CMP2>(c, q, o, lds, tid, wv);
    {
        u64 wlo = 0, whi2 = 0;
        for (int k = 0; k < 8; ++k) {
            const int qq = w * 8 + k, tq = qb * 64 + qq;
            LAS float* ig = (LAS float*)(lds + A_IMPG) + qq * 128; const LAS float* i3 = (const LAS float*)(lds + A_IMP3) + qq * 128;
            const int j0 = lane, j1 = lane + 64;
            const bool f0 = (j0 == 0) | (j0 == qb) | (j0 == qb - 1), f1 = (j1 == qb) | (j1 == qb - 1);
            const bool va0 = j0 * 64 <= tq, va1 = j1 * 64 <= tq;
            const float v0 = f0 ? 1e9f : (va0 ? ig[j0] + i3[j0] : -1e9f), v1 = f1 ? 1e9f : (va1 ? ig[j1] + i3[j1] : -1e9f);
            const unsigned b0 = __builtin_bit_cast(unsigned, v0), b1 = __builtin_bit_cast(unsigned, v1);
            const unsigned k0 = b0 ^ ((b0 >> 31) ? 0xFFFFFFFFu : 0x80000000u), k1 = b1 ^ ((b1 >> 31) ? 0xFFFFFFFFu : 0x80000000u);
            unsigned th = 0u;
#pragma unroll 4
            for (int bit = 31; bit >= 0; --bit) {
                const unsigned trial = th | (1u << bit);
                const int cnt = __popcll(__ballot(k0 >= trial)) + __popcll(__ballot(k1 >= trial));
                th = (cnt >= 16) ? trial : th;
            }
            const u64 gt0 = __ballot(k0 > th), gt1 = __ballot(k1 > th), eq0 = __ballot(k0 == th), eq1 = __ballot(k1 == th);
            const int need = 16 - (__popcll(gt0) + __popcll(gt1));
            const u64 below = (lane == 0) ? 0ull : (~0ull >> (64 - lane));
            const int pos0 = __popcll(eq0 & below), pos1 = __popcll(eq0) + __popcll(eq1 & below);
            const bool s0 = (k0 > th) || (k0 == th && pos0 < need), s1 = (k1 > th) || (k1 == th && pos1 < need);
            const u64 lo = __ballot(s0 && va0), hi = __ballot(s1 && va1);
            if (lane == 0) { *(LAS u64*)(lds + A_SEL + qq * 16) = lo; *(LAS u64*)(lds + A_SEL + qq * 16 + 8) = hi; }
            wlo |= lo; whi2 |= hi;
        }
        if (lane == 0) { *(LAS u64*)(lds + A_WUN + w * 16) = wlo; *(LAS u64*)(lds + A_WUN + w * 16 + 8) = whi2; }
        c.wun_lo = wlo; c.wun_hi = whi2;
        __syncthreads();
        if (tid == 0) {
            u64 ulo = 0, uhi = 0;
            for (int k = 0; k < 8; ++k) { ulo |= *(LAS u64*)(lds + A_WUN + k * 16); uhi |= *(LAS u64*)(lds + A_WUN + k * 16 + 8); }
            LAS int* list = (LAS int*)(lds + A_LIST); int cnt = 0;
            for (int j = 63; j >= 0; --j) if ((uhi >> j) & 1ull) list[cnt++] = 64 + j;
            for (int j = 63; j >= 0; --j) if ((ulo >> j) & 1ull) list[cnt++] = j;
            list[128] = cnt;
        }
        __syncthreads();
        c.ntiles = ((LAS int*)(lds + A_LIST))[128];
    }
    nsa_store<0>(o, NSA_GATE(0), NSA_OACC, NSA_OROW);
    zero_o(o); c.m = NINF; c.l = 0.f; c.tile0 = 0; c.whi = 1 << 30;
    c.kmat = heads + ((size_t)(28 + g) * M + b * T) * HD; c.vtm = VT + ((size_t)(8 + g) * (M / 64) + b * (T / 64)) * 8192; c.vpitch = 64;
    attn_run<MD_SEL>(c, q, o, lds, tid, wv);
    { const float lt = c.l + shx(c.l, 32, lane); nsa_store<1>(o, lt > 0.f ? NSA_GATE(1) / lt : 0.f, NSA_OACC, NSA_OROW); }
    zero_o(o); c.m = NINF; c.l = 0.f; c.tile0 = qb >= 8 ? qb - 8 : 0; c.ntiles = qb - c.tile0 + 1; c.whi = 1 << 30;
    c.kmat = heads + ((size_t)(30 + g) * M + b * T) * HD; c.vtm = VT + ((size_t)(10 + g) * (M / 64) + b * (T / 64)) * 8192;
    attn_run<MD_WIN>(c, q, o, lds, tid, wv);
    { const float lt = c.l + shx(c.l, 32, lane); nsa_store<2>(o, lt > 0.f ? NSA_GATE(2) / lt : 0.f, NSA_OACC, NSA_OROW); }
    __syncthreads();
}
#define XB_TMO      128
#define XB_XCNT(j)  (256  + 64 * (j))
#define XB_XSUB(j)  (1280 + 64 * (j))
#define XB_XGEN(j)  (2304 + 64 * (j))
#define XB_TOP      3328
#define XB_TOPGEN   3392
#define XCD_BAR_WORDS 3456
#define XB_SPIN_CAP (1u << 18)

__device__ __forceinline__ unsigned xb_ld(unsigned* p)              { return __hip_atomic_load(p, __ATOMIC_RELAXED, __HIP_MEMORY_SCOPE_AGENT); }
__device__ __forceinline__ unsigned xb_add(unsigned* p, unsigned v) { return __hip_atomic_fetch_add(p, v, __ATOMIC_RELAXED, __HIP_MEMORY_SCOPE_AGENT); }
__device__ __forceinline__ unsigned xb_xcc_id() { return (unsigned)__builtin_amdgcn_s_getreg((3 << 11) | 20) & 0xFu; }
#define XB_SPIN(cond, bar) do { unsigned _sp = 0; while (cond) { __builtin_amdgcn_s_sleep(1); \
    if ((++_sp & 255u) == 0u) { if (xb_ld(&(bar)[XB_TMO])) break; if (_sp > XB_SPIN_CAP) { atomicAdd(&(bar)[XB_TMO], 1u); break; } } } } while (0)

struct XcdBarrier {
    unsigned* bar; unsigned x;
    volatile LAS unsigned* st;
};

__device__ __forceinline__ XcdBarrier xcd_barrier_post(unsigned* bar, volatile LAS unsigned* st, bool leader) {
    XcdBarrier b; b.bar = bar; b.x = xb_xcc_id(); b.st = st;
    if (leader) (void)xb_add(&bar[XB_XCNT(b.x)], 1u);
    return b;
}
__device__ __forceinline__ void xcd_barrier_complete(unsigned* bar, unsigned x, unsigned& nloc, unsigned& nx) {
    const unsigned G = gridDim.x * gridDim.y * gridDim.z;
    unsigned sum, cnt, mine, sp = 0u;
    for (;;) {
        sum = 0u; cnt = 0u; mine = 0u;
#pragma unroll
        for (unsigned j = 0; j < 16; ++j) { const unsigned c = xb_ld(&bar[XB_XCNT(j)]); sum += c; cnt += (c > 0u) ? 1u : 0u; mine = (j == x) ? c : mine; }
        if (sum == G) break;
        __builtin_amdgcn_s_sleep(1);
        if ((++sp & 255u) == 0u) { if (xb_ld(&bar[XB_TMO])) break; if (sp > XB_SPIN_CAP) { atomicAdd(&bar[XB_TMO], 1u); break; } }
    }
    nloc = mine > 0u ? mine : 1u; nx = cnt > 0u ? cnt : 1u;
}

__device__ __forceinline__ void xcd_barrier(const XcdBarrier& b, bool leader) {
    asm volatile("s_waitcnt vmcnt(0)" ::: "memory");
    __syncthreads();
    if (leader) {
        unsigned* bar = b.bar;
        __builtin_amdgcn_s_waitcnt(0);
        unsigned nloc = b.st[0], nx = b.st[1];
        if (nloc == 0u) { xcd_barrier_complete(bar, b.x, nloc, nx); b.st[0] = nloc; b.st[1] = nx; }
        const unsigned old = xb_add(&bar[XB_XSUB(b.x)], 1u);
        const unsigned gen = old / nloc;
        if (old + 1u == (gen + 1u) * nloc) {
            __builtin_amdgcn_fence(__ATOMIC_RELEASE, "agent");
            asm volatile("s_waitcnt vmcnt(0)" ::: "memory");
            const unsigned og = xb_add(&bar[XB_TOP], 1u);
            const unsigned tg = og / nx;
            if (og + 1u == (tg + 1u) * nx) xb_add(&bar[XB_TOPGEN], 1u);
            else XB_SPIN(xb_ld(&bar[XB_TOPGEN]) == tg, bar);
            __builtin_amdgcn_fence(__ATOMIC_ACQUIRE, "agent");
            xb_add(&bar[XB_XGEN(b.x)], 1u);
            asm volatile("s_waitcnt vmcnt(0)" ::: "memory");
        } else {
            XB_SPIN(xb_ld(&bar[XB_XGEN(b.x)]) == gen, bar);
            __builtin_amdgcn_fence(__ATOMIC_ACQUIRE, "agent");
            asm volatile("s_waitcnt vmcnt(0)" ::: "memory");
        }
    }
    __syncthreads();
}

__global__ void __launch_bounds__(NTHR, 2) hybrid_fwd(P p) {
    extern __shared__ __attribute__((aligned(16))) unsigned char lds_raw[];
    ldsp lds = (ldsp)lds_raw;
    cg::grid_group grid = cg::this_grid();
    const int G0 = gridDim.x;

#ifndef PHMASK
#define PHMASK 0xFFFF
#endif
#define PH(k) ((PHMASK >> (k)) & 1)
    const int wv = __builtin_amdgcn_readfirstlane((int)threadIdx.x >> 6);
    volatile LAS unsigned* bst = (volatile LAS unsigned*)(lds + LDS_BYTES - 64);
    if (threadIdx.x < 2) bst[threadIdx.x] = 0u;
    __syncthreads();
    XcdBarrier bar = xcd_barrier_post((unsigned*)(p.ws + WS_BAR), bst, threadIdx.x == 0);
#define SEAM() xcd_barrier(bar, wv == 0 && tid_of(wv) == 0)
    if (PH(0)) prologue(p, lds, G0, wv);
    grid.sync();

#pragma unroll
    for (int l = 0; l < 2; ++l) {
        const int tid = tid_of(wv);
        int G = gridDim.x, c = blockIdx.x; asm volatile("" : "+s"(G), "+s"(c));
        unsigned char* ws = p.ws; asm volatile("" : "+s"(ws));
        bf16* XB = (bf16*)(ws + WS_XB); bf16* HEADS = (bf16*)(ws + WS_HEADS); bf16* VT = (bf16*)(ws + WS_VT); bf16* HB = (bf16*)(ws + WS_H); bf16* OMIX = (bf16*)(ws + WS_OMIX);
        float* SCAL = (float*)(ws + WS_SCAL); float* SS = (float*)(ws + WS_SS); float* PB = (float*)(ws + WS_PB);
        unsigned char* wl = ws + (size_t)l * WL;
        const float* ssA = SS + (size_t)(2 * l) * M; float* ssF = SS + (size_t)(2 * l + 1) * M; float* ssN = (l == 0) ? SS + (size_t)2 * M : nullptr;
        if (PH(1)) { pg8::Gemm g{XB, (const bf16*)(wl + OW1), M, N1, DM, DM, DM, (const bf16*)(wl + OW2), XB}; MergedOrder S; S.init(G, c);
          EpiInProj E{{HEADS, SCAL, ssA}, {VT, ssA}};
          pg8::gemm_phase<EpiInProj, MergedOrder, true, true>(lds, g, S, E, wv); }
        SEAM();
        if (PH(3) && (c < 16 || c >= 48)) post_norm(p, l, G - 32, c < 16 ? c : c - 32, wv);
        if (c >= 48) {
            convert_weights(p, lds, l, 1, G - 48, c - 48, wv);
            if (l == 0) convert_weights(p, lds, 1, 0, G - 48, c - 48, wv);
        }
        if (PH(4) && c < 16) post_cumsum(p, l, lds, c, wv);
        else if (PH(5) && c >= 16 && c < 48) {
            const int cu = c - 16, isv = cu >> 4, unit = (cu & 15) >> 1, half = cu & 1;
            float* kraw = (float*)(ws + WS_KRAW2); float* vraw = (float*)(ws + WS_VRAW2);
            const bf16* spans = HEADS + (size_t)(isv ? 26 : 24) * M * HD + half * 2048;
            const bf16* wct = (const bf16*)(wl + OWC) + half * 2048;
            if (!isv) { pg8::Gemm g{spans, wct, 2048, 256, 2048, 2048, 4096}; OneUnit S{true, {unit, 0}};
                EpiCmpK E{kraw + (size_t)half * 2048 * 128};
                pg8::gemm_phase<EpiCmpK, OneUnit, false, true>(lds, g, S, E, wv); }
            else { pg8::Gemm g{wct, spans, 256, 2048, 2048, 4096, 2048}; OneUnit S{true, {0, unit}};
                EpiCmpVraw E{vraw + (size_t)half * 128 * 2048};
                pg8::gemm_phase<EpiCmpVraw, OneUnit, false, true>(lds, g, S, E, wv); }
            __builtin_amdgcn_fence(__ATOMIC_RELEASE, "agent");
            __syncthreads();
            volatile LAS unsigned* cslot = (volatile LAS unsigned*)(lds + LDS_BYTES - 32);
            if (tid == 0) *cslot = __hip_atomic_fetch_add((unsigned*)(ws + WS_CCTR) + l * 16 + isv * 8 + unit, 1u, __ATOMIC_RELAXED, __HIP_MEMORY_SCOPE_AGENT);
            __syncthreads();
            if (*cslot == 1u) {
                __builtin_amdgcn_fence(__ATOMIC_ACQUIRE, "agent");
                const int lane = tid & 63, wave = tid >> 6, sub = lane & 15;
                if (!isv) {
                    const float* pbk = PB + (l * 2 + 0) * 128 + sub * 8; const float* gp = p.ckn + l * HD + sub * 8;
                    bf16* kcmp = (bf16*)(ws + WS_KCMP);
                    for (int it = wave; it < 64; it += NWAVES) {
                        const int row = unit * 256 + it * 4 + (lane >> 4);
                        const float* src = kraw + (size_t)row * HD + sub * 8;
                        float v[8]; float sq = 0.f;
#pragma unroll
                        for (int j = 0; j < 8; ++j) { v[j] = src[j] + src[2048 * 128 + j] + pbk[j]; sq += v[j] * v[j]; }
                        sq += shx(sq, 1, lane); sq += shx(sq, 2, lane); sq += shx(sq, 4, lane); sq += shx(sq, 8, lane);
                        const float rs = rsqrtf(sq * (1.0f / HD) + EPS);
                        u32x4 ov; ov.x = pk2(v[0] * rs * gp[0], v[1] * rs * gp[1]); ov.y = pk2(v[2] * rs * gp[2], v[3] * rs * gp[3]);
                        ov.z = pk2(v[4] * rs * gp[4], v[5] * rs * gp[5]); ov.w = pk2(v[6] * rs * gp[6], v[7] * rs * gp[7]);
                        *(u32x4*)(kcmp + (size_t)row * HD + sub * 8) = ov;
                    }
                } else {
                    const float* pbv = PB + (l * 2 + 1) * 128; bf16* vct = (bf16*)(ws + WS_VCT);
                    for (int it = tid; it < 128 * 32; it += NTHR) {
                        const int e = it >> 5, R = unit * 256 + (it & 31) * 8;
                        const float* src = vraw + (size_t)e * 2048 + R; const float pb = pbv[e];
                        const f32x4 a0 = *(const f32x4*)src + *(const f32x4*)(src + 128 * 2048) + pb, a1 = *(const f32x4*)(src + 4) + *(const f32x4*)(src + 128 * 2048 + 4) + pb;
                        u32x4 ov; ov.x = pk2(a0[0], a0[1]); ov.y = pk2(a0[2], a0[3]); ov.z = pk2(a1[0], a1[1]); ov.w = pk2(a1[2], a1[3]);
                        *(u32x4*)(vct + ((size_t)(R >> 6) * 128 + e) * 64 + (R & 63)) = ov;
                    }
                }
            }
            __syncthreads();
        }
        SEAM();
        {
            unsigned* qctr = (unsigned*)(ws + WS_QCTR) + l * 64;
            volatile LAS unsigned* qslot = (volatile LAS unsigned*)(lds + LDS_BYTES - 32);
            for (;;) {
                if (tid == 0) *qslot = atomicAdd(qctr, 1u);
                __syncthreads();
                const int v = (int)*qslot;
                __syncthreads();
                if (v >= 1024) break;
                if (v < 512) { const int gg = v < 256 ? 1 : 0, idx = v & 255; if (PH(8)) nsa_unit(p, lds, (idx >> 1) * 4 + ((idx & 1) * 2 + gg), l, wv); }
                else { if (PH(7)) fox_unit(p, lds, v - 512, l, wv); }
            }
        }
        SEAM();
        if (PH(9)) { pg8::Gemm g{OMIX, (const bf16*)(wl + OWO), M, DM, DM, DM, DM}; pg8::StaticOrder S; S.init(M, DM, G, c);
          EpiRes E{nullptr, XB, ssF, lds + 131072};
          pg8::gemm_phase<EpiRes, pg8::StaticOrder, true, true>(lds, g, S, E, wv); }
        SEAM();
        if (PH(10)) { pg8::Gemm g{XB, (const bf16*)(wl + OWGU), M, NGU, DM, DM, DM}; pg8::StaticOrder S; S.init(M, NGU, G, c);
          EpiGU E{HB, ssF};
          pg8::gemm_phase<EpiGU, pg8::StaticOrder, true, true>(lds, g, S, E, wv); }
        SEAM();
        if (PH(11)) { pg8::Gemm g{HB, (const bf16*)(wl + OWD), M, DM, FF, FF, FF}; pg8::StaticOrder S; S.init(M, DM, G, c);
          EpiRes E{l == 1 ? p.out : nullptr, XB, ssN, lds + 131072};
          pg8::gemm_phase<EpiRes, pg8::StaticOrder, true, true>(lds, g, S, E, wv); }
        if (l == 0) SEAM();
    }
}

extern "C" void kernel_launch(void* const* d_in, const int* in_sizes, int n_in, void* d_out, int out_size, void* d_ws, size_t ws_size, hipStream_t stream) {
    static int grid_blocks = 0;
    if (grid_blocks == 0) {
        if (n_in != 19 || ws_size < WS_END) { fprintf(stderr, "kernel_launch: unexpected n_in %d / ws_size %zu (need %zu)\n", n_in, ws_size, (size_t)WS_END); grid_blocks = -1; return; }
        int dev = 0, cus = 0, per_cu = 0;
        hipGetDevice(&dev); hipDeviceGetAttribute(&cus, hipDeviceAttributeMultiprocessorCount, dev);
        if (hipFuncSetAttribute((const void*)hybrid_fwd, hipFuncAttributeMaxDynamicSharedMemorySize, LDS_BYTES) != hipSuccess) fprintf(stderr, "kernel_launch: hipFuncSetAttribute failed\n");
        if (hipOccupancyMaxActiveBlocksPerMultiprocessor(&per_cu, (const void*)hybrid_fwd, NTHR, LDS_BYTES) != hipSuccess || per_cu < 1) { fprintf(stderr, "kernel_launch: occupancy query says %d\n", per_cu); per_cu = 1; }
        (void)hipGetLastError();
        grid_blocks = cus;
        if (grid_blocks < 64) { fprintf(stderr, "kernel_launch: too few CUs (%d)\n", grid_blocks); grid_blocks = -1; return; }
    }
    if (grid_blocks < 0) return;
    hipMemsetAsync((char*)d_ws + ZERO_OFF, 0, ZERO_BYTES, stream);
    P p{};
    const float** pp = (const float**)&p;
    for (int i = 0; i < 19; ++i) pp[i] = (const float*)d_in[i];
    p.out = (float*)d_out; p.ws = (unsigned char*)d_ws;
    void* args[] = {&p};
    hipError_t e = hipLaunchCooperativeKernel((const void*)hybrid_fwd, dim3(grid_blocks), dim3(NTHR), args, LDS_BYTES, stream);
    if (e != hipSuccess) fprintf(stderr, "cooperative launch failed: %s (grid %d)\n", hipGetErrorString(e), grid_blocks);
}
```
